# Optimizing an MI355X kernel written in HIP

```python
import math
import jax
import jax.numpy as jnp
from jax import lax
import numpy as np

D_MODEL = 2048
BATCH = 1
SEQ = 16384
DEPTH = 2

GRID_W = 64
CTX_LEN = 256
HEAD_DIM = 64
MIX_WIDTH = D_MODEL // 4
N_BRANCH = 4
A_HEADS = MIX_WIDTH // HEAD_DIM
A_KV_HEADS = A_HEADS // 4
A_WINDOW = 128
A_BLOCK = 128
ROPE_BASE = 10000.0
ROPE_PAIRS = HEAD_DIM // 4
S5_GROUP_CH = 16
S5_GROUPS = MIX_WIDTH // S5_GROUP_CH
S5_STATE = 64
S5_DT_MIN = 0.001
S5_DT_MAX = 0.1
C_HEADS = MIX_WIDTH // HEAD_DIM
C_WIN_R = 8
C_WIN_C = 16
C_QBLOCK = 16
C_KBLOCK = C_QBLOCK + C_WIN_C
CONV_WIDTH = MIX_WIDTH
CONV_K = 31
D_FF = 4 * D_MODEL
EPS = 1e-6
NEG_INF = -1e30

kernel_name = 'hybrid_gated_diffusion_block'


def _in_widths():
    return (A_HEADS * HEAD_DIM, A_KV_HEADS * HEAD_DIM, A_KV_HEADS * HEAD_DIM,
            MIX_WIDTH,
            C_HEADS * HEAD_DIM, C_HEADS * HEAD_DIM, C_HEADS * HEAD_DIM,
            CONV_WIDTH, CONV_WIDTH,
            D_MODEL, D_MODEL, D_MODEL, D_MODEL)


def _split_points():
    return np.cumsum(np.array(_in_widths()))[:-1].tolist()


def rms_norm(x, g):
    xf = x.astype(jnp.float32)
    y = xf * lax.rsqrt(jnp.mean(xf * xf, axis=-1, keepdims=True) + EPS)
    return (y * g.astype(jnp.float32)).astype(x.dtype)


def modulate(h, shift, scale):
    return h * (1.0 + scale) + shift


def heads(t, n):
    return t.reshape(t.shape[0], t.shape[1], n, HEAD_DIM)


def axial_rope(x, cos, sin):
    B, L, H, Dh = x.shape
    xf = x.astype(jnp.float32).reshape(B, L, H, 2, 2, ROPE_PAIRS)
    x1, x2 = xf[..., 0, :], xf[..., 1, :]
    cs, sn = cos[None, :, None], sin[None, :, None]
    out = jnp.stack([x1 * cs - x2 * sn, x1 * sn + x2 * cs], axis=-2)
    return out.reshape(B, L, H, Dh).astype(x.dtype)


def window_attention(q, k, v, k_ctx, v_ctx, sink):
    B, L, Hq, Dh = q.shape
    Hkv = k.shape[2]
    G = Hq // Hkv
    Lc = k_ctx.shape[1]
    nb = L // A_BLOCK
    nw = 3 * A_BLOCK
    scale = Dh ** -0.5
    qb = q.reshape(B, nb, A_BLOCK, Hkv, G, Dh)
    pad = ((0, 0), (A_BLOCK, A_BLOCK), (0, 0), (0, 0))
    kp = jnp.pad(k, pad).reshape(B, nb + 2, A_BLOCK, Hkv, Dh)
    vp = jnp.pad(v, pad).reshape(B, nb + 2, A_BLOCK, Hkv, Dh)
    kw = jnp.concatenate([kp[:, :-2], kp[:, 1:-1], kp[:, 2:]], axis=2)
    vw = jnp.concatenate([vp[:, :-2], vp[:, 1:-1], vp[:, 2:]], axis=2)
    qi = np.arange(A_BLOCK)[:, None]
    kj = np.arange(nw)[None, :] - A_BLOCK
    kabs = np.arange(nb)[:, None, None] * A_BLOCK + kj[None]
    mask = (np.abs(kj - qi) <= A_WINDOW)[None] & (kabs >= 0) & (kabs < L)
    s_win = jnp.einsum('bnqhgd,bnkhd->bnhgqk', qb, kw).astype(jnp.float32) * scale
    s_win = jnp.where(jnp.asarray(mask)[None, :, None, None], s_win, NEG_INF)
    s_ctx = jnp.einsum('bnqhgd,bchd->bnhgqc', qb, k_ctx).astype(jnp.float32) * scale
    s_sink = jnp.broadcast_to(sink.astype(jnp.float32).reshape(1, 1, Hkv, G, 1, 1), s_win.shape[:-1] + (1,))
    p = jax.nn.softmax(jnp.concatenate([s_win, s_ctx, s_sink], axis=-1), axis=-1).astype(v.dtype)
    o = (jnp.einsum('bnhgqk,bnkhd->bnqhgd', p[..., :nw], vw)
         + jnp.einsum('bnhgqc,bchd->bnqhgd', p[..., nw:nw + Lc], v_ctx))
    return o.reshape(B, L, Hq * Dh)


def context_attention(q, k, v, sink):
    B, Lc, Hq, Dh = q.shape
    Hkv = k.shape[2]
    G = Hq // Hkv
    qg = q.reshape(B, Lc, Hkv, G, Dh)
    s = jnp.einsum('bqhgd,bkhd->bhgqk', qg, k).astype(jnp.float32) * (Dh ** -0.5)
    if sink is not None:
        s_sink = jnp.broadcast_to(sink.astype(jnp.float32).reshape(1, Hkv, G, 1, 1), s.shape[:-1] + (1,))
        s = jnp.concatenate([s, s_sink], axis=-1)
    p = jax.nn.softmax(s, axis=-1)[..., :Lc].astype(v.dtype)
    o = jnp.einsum('bhgqk,bkhd->bqhgd', p, v)
    return o.reshape(B, Lc, Hq * Dh)


def neighborhood_attention(q, k, v, k_ctx, v_ctx, rpb, rows):
    B, L, H, Dh = q.shape
    wr = min(C_WIN_R, rows)
    ncb = GRID_W // C_QBLOCK
    nk = wr * C_KBLOCK
    scale = Dh ** -0.5
    r = np.arange(rows)
    krow = np.clip(r - C_WIN_R // 2, 0, rows - wr)[:, None] + np.arange(wr)[None]
    qcol = np.arange(GRID_W).reshape(ncb, C_QBLOCK)
    kcol = (np.clip(np.arange(ncb) * C_QBLOCK - C_WIN_C // 2, 0, GRID_W - C_KBLOCK)[:, None]
            + np.arange(C_KBLOCK)[None])
    cstart = np.clip(qcol - C_WIN_C // 2, 0, GRID_W - C_WIN_C)
    col_ok = (kcol[:, None, :] >= cstart[..., None]) & (kcol[:, None, :] < cstart[..., None] + C_WIN_C)
    mask = np.broadcast_to(col_ok[:, :, None, :], (ncb, C_QBLOCK, wr, C_KBLOCK)).reshape(ncb, C_QBLOCK, nk)
    idx = jnp.asarray((krow[:, None, :, None] * GRID_W + kcol[None, :, None, :]).reshape(-1))
    kg = jnp.take(k, idx, axis=1).reshape(B, rows, ncb, nk, H, Dh)
    vg = jnp.take(v, idx, axis=1).reshape(B, rows, ncb, nk, H, Dh)
    qb = q.reshape(B, rows, ncb, C_QBLOCK, H, Dh)
    dr = (krow - r[:, None] + C_WIN_R - 1)[:, None, None, :, None]
    dc = np.clip(kcol[:, None, :] - qcol[:, :, None] + C_WIN_C - 1, 0, 2 * C_WIN_C - 2)[None, :, :, None, :]
    bias = jnp.moveaxis(rpb.astype(jnp.float32)[:, dr, dc], 0, 2).reshape(rows, ncb, H, C_QBLOCK, nk)
    s = jnp.einsum('brjqhd,brjkhd->brjhqk', qb, kg).astype(jnp.float32) * scale + bias
    s = jnp.where(jnp.asarray(mask)[None, None, :, None], s, NEG_INF)
    s_ctx = jnp.einsum('brjqhd,bchd->brjhqc', qb, k_ctx).astype(jnp.float32) * scale
    p = jax.nn.softmax(jnp.concatenate([s, s_ctx], axis=-1), axis=-1).astype(v.dtype)
    o = (jnp.einsum('brjhqk,brjkhd->brjqhd', p[..., :nk], vg)
         + jnp.einsum('brjhqc,bchd->brjqhd', p[..., nk:], v_ctx))
    return o.reshape(B, L, H * Dh)


def _zoh(a_re, a_im, log_step, b_re, b_im):
    f32 = jnp.float32
    ar, ai = a_re.astype(f32), a_im.astype(f32)
    step = jnp.exp(log_step.astype(f32))[:, None]
    mag = jnp.exp(ar * step)
    ab_re, ab_im = mag * jnp.cos(ai * step), mag * jnp.sin(ai * step)
    den = ar * ar + ai * ai
    nr = ab_re - 1.0
    f_re = (nr * ar + ab_im * ai) / den
    f_im = (ab_im * ar - nr * ai) / den
    br, bi = b_re.astype(f32), b_im.astype(f32)
    bb_re = f_re[..., None] * br - f_im[..., None] * bi
    bb_im = f_re[..., None] * bi + f_im[..., None] * br
    return ab_re, ab_im, bb_re, bb_im


def _diag_scan(ab_re, ab_im, bu_re, bu_im):
    a_re = jnp.broadcast_to(ab_re, bu_re.shape)
    a_im = jnp.broadcast_to(ab_im, bu_im.shape)

    def combine(e1, e2):
        a1r, a1i, b1r, b1i = e1
        a2r, a2i, b2r, b2i = e2
        return (a2r * a1r - a2i * a1i, a2r * a1i + a2i * a1r,
                a2r * b1r - a2i * b1i + b2r, a2r * b1i + a2i * b1r + b2i)

    _, _, h_re, h_im = lax.associative_scan(combine, (a_re, a_im, bu_re, bu_im), axis=1)
    return h_re, h_im


def _chained_scan(ab_re, ab_im, bu_ctx, bu_lat):
    hc_re, hc_im = _diag_scan(ab_re, ab_im, bu_ctx[0], bu_ctx[1])
    s_re, s_im = hc_re[:, -1], hc_im[:, -1]
    lr = bu_lat[0].at[:, 0].add(ab_re * s_re - ab_im * s_im)
    li = bu_lat[1].at[:, 0].add(ab_re * s_im + ab_im * s_re)
    hl_re, hl_im = _diag_scan(ab_re, ab_im, lr, li)
    return (hc_re, hc_im), (hl_re, hl_im)


def s5_mixer(u_ctx, u_lat, a_re, a_im, log_step, b_re, b_im, c_re, c_im, d_skip, glu_w, glu_b, need_ctx):
    f32 = jnp.float32
    B, L, W = u_lat.shape
    Lc = u_ctx.shape[1]
    uc = u_ctx.astype(f32).reshape(B, Lc, S5_GROUPS, S5_GROUP_CH)
    ul = u_lat.astype(f32).reshape(B, L, S5_GROUPS, S5_GROUP_CH)
    dsk = d_skip.astype(f32).reshape(S5_GROUPS, S5_GROUP_CH)
    yl = ul * dsk
    yc = uc * dsk
    for d in range(2):
        ab_re, ab_im, bb_re, bb_im = _zoh(a_re[d], a_im[d], log_step[d], b_re[d], b_im[d])
        cr, ci = c_re[d].astype(f32), c_im[d].astype(f32)
        uc_d = uc if d == 0 else jnp.flip(uc, axis=1)
        ul_d = ul if d == 0 else jnp.flip(ul, axis=1)
        drive_c = (jnp.einsum('blgh,gph->blgp', uc_d, bb_re), jnp.einsum('blgh,gph->blgp', uc_d, bb_im))
        drive_l = (jnp.einsum('blgh,gph->blgp', ul_d, bb_re), jnp.einsum('blgh,gph->blgp', ul_d, bb_im))
        (hcr, hci), (hlr, hli) = _chained_scan(ab_re, ab_im, drive_c, drive_l)
        out_l = jnp.einsum('blgp,ghp->blgh', hlr, cr) - jnp.einsum('blgp,ghp->blgh', hli, ci)
        yl = yl + (out_l if d == 0 else jnp.flip(out_l, axis=1))
        if need_ctx:
            out_c = jnp.einsum('blgp,ghp->blgh', hcr, cr) - jnp.einsum('blgp,ghp->blgh', hci, ci)
            yc = yc + (out_c if d == 0 else jnp.flip(out_c, axis=1))

    def glu(y):
        g = jax.nn.gelu(y)
        return g * jax.nn.sigmoid(g @ glu_w.astype(f32) + glu_b.astype(f32))

    y_lat = glu(yl.reshape(B, L, W)).astype(u_lat.dtype)
    y_ctx = glu(yc.reshape(B, Lc, W)).astype(u_ctx.dtype) if need_ctx else None
    return y_ctx, y_lat


def conv_module(val, gate, w, b, g, beta):
    h = val * jax.nn.sigmoid(gate)
    ch = h.shape[-1]
    y = lax.conv_general_dilated(h, w[:, None, :].astype(h.dtype), window_strides=(1,),
                                 padding=[(CONV_K // 2, CONV_K // 2)],
                                 dimension_numbers=('NWC', 'WIO', 'NWC'),
                                 feature_group_count=ch) + b
    yf = y.astype(jnp.float32)
    mu = jnp.mean(yf, axis=-1, keepdims=True)
    var = jnp.mean(jnp.square(yf - mu), axis=-1, keepdims=True)
    yn = (yf - mu) * lax.rsqrt(var + EPS) * g.astype(jnp.float32) + beta.astype(jnp.float32)
    return jax.nn.silu(yn).astype(val.dtype)


def gated_merge(ys, gate_logits, w_branch, w_out):
    m = jax.nn.sigmoid(gate_logits[0]) * (ys[0] @ w_branch[0])
    for i in range(1, N_BRANCH):
        m = m + jax.nn.sigmoid(gate_logits[i]) * (ys[i] @ w_branch[i])
    return m @ w_out


def hybrid_mixer(hx, hz, cos, sin, rows, w_in, a_sink, s5_a_re, s5_a_im, s5_log_step, s5_b_re, s5_b_im,
                 s5_c_re, s5_c_im, s5_d, s5_glu_w, s5_glu_b, c_rpb, d_conv_w, d_conv_b, d_ln_g, d_ln_b,
                 w_branch, w_out, need_ctx):
    sp = _split_points()
    px = jnp.split(hx @ w_in, sp, axis=-1)
    pz = jnp.split(hz @ w_in, sp, axis=-1)
    qa = axial_rope(heads(px[0], A_HEADS), cos, sin)
    ka = axial_rope(heads(px[1], A_KV_HEADS), cos, sin)
    va = heads(px[2], A_KV_HEADS)
    kza, vza = heads(pz[1], A_KV_HEADS), heads(pz[2], A_KV_HEADS)
    ya_x = window_attention(qa, ka, va, kza, vza, a_sink)
    yb_z, yb_x = s5_mixer(pz[3], px[3], s5_a_re, s5_a_im, s5_log_step, s5_b_re, s5_b_im,
                          s5_c_re, s5_c_im, s5_d, s5_glu_w, s5_glu_b, need_ctx)
    kzc, vzc = heads(pz[5], C_HEADS), heads(pz[6], C_HEADS)
    yc_x = neighborhood_attention(heads(px[4], C_HEADS), heads(px[5], C_HEADS), heads(px[6], C_HEADS),
                                  kzc, vzc, c_rpb, rows)
    yd_x = conv_module(px[7], px[8], d_conv_w, d_conv_b, d_ln_g, d_ln_b)
    out_x = gated_merge((ya_x, yb_x, yc_x, yd_x), px[9:13], w_branch, w_out)
    if not need_ctx:
        return out_x, None
    ya_z = context_attention(heads(pz[0], A_HEADS), kza, vza, a_sink)
    yc_z = context_attention(heads(pz[4], C_HEADS), kzc, vzc, None)
    yd_z = conv_module(pz[7], pz[8], d_conv_w, d_conv_b, d_ln_g, d_ln_b)
    out_z = gated_merge((ya_z, yb_z, yc_z, yd_z), pz[9:13], w_branch, w_out)
    return out_x, out_z


def squared_relu_mlp(h, w1, w2):
    return jnp.square(jax.nn.relu(h @ w1)) @ w2


def setup_inputs(seed: int = 0) -> dict:
    key = jax.random.key(seed)
    ks = iter(jax.random.split(key, 40))
    f32 = jnp.float32

    def nrm(shape, std):
        return jax.random.normal(next(ks), shape, f32) * std

    Dm = D_MODEL
    n_in = int(sum(_in_widths()))
    s5_shape = (DEPTH, 2, S5_GROUPS, S5_STATE)
    n_idx = jnp.arange(S5_STATE, dtype=f32)
    return {
        'x': nrm((BATCH, SEQ, Dm), 1.0),
        'c': nrm((BATCH, Dm), 1.0),
        'ctx': nrm((BATCH, CTX_LEN, Dm), 1.0),
        'c_ctx': nrm((Dm,), 1.0),
        'ada_w': nrm((DEPTH, Dm, 6 * Dm), 0.5 * Dm ** -0.5),
        'ada_b': nrm((DEPTH, 6 * Dm), 0.01),
        'norm1_g': 1.0 + nrm((DEPTH, Dm), 0.05),
        'norm2_g': 1.0 + nrm((DEPTH, Dm), 0.05),
        'w_in': nrm((DEPTH, Dm, n_in), Dm ** -0.5),
        'a_sink': nrm((DEPTH, A_HEADS), 1.0),
        's5_a_re': -0.5 + nrm(s5_shape, 0.01),
        's5_a_im': jnp.broadcast_to(math.pi * n_idx, s5_shape) + nrm(s5_shape, 0.01),
        's5_log_step': jax.random.uniform(next(ks), (DEPTH, 2, S5_GROUPS), f32,
                                          math.log(S5_DT_MIN), math.log(S5_DT_MAX)),
        's5_b_re': nrm((DEPTH, 2, S5_GROUPS, S5_STATE, S5_GROUP_CH), (0.5 / S5_GROUP_CH) ** 0.5),
        's5_b_im': nrm((DEPTH, 2, S5_GROUPS, S5_STATE, S5_GROUP_CH), (0.5 / S5_GROUP_CH) ** 0.5),
        's5_c_re': nrm((DEPTH, 2, S5_GROUPS, S5_GROUP_CH, S5_STATE), (0.5 / S5_STATE) ** 0.5),
        's5_c_im': nrm((DEPTH, 2, S5_GROUPS, S5_GROUP_CH, S5_STATE), (0.5 / S5_STATE) ** 0.5),
        's5_d': nrm((DEPTH, MIX_WIDTH), 1.0),
        's5_glu_w': nrm((DEPTH, MIX_WIDTH, MIX_WIDTH), MIX_WIDTH ** -0.5),
        's5_glu_b': nrm((DEPTH, MIX_WIDTH), 0.01),
        'c_rpb': nrm((DEPTH, C_HEADS, 2 * C_WIN_R - 1, 2 * C_WIN_C - 1), 0.1),
        'd_conv_w': nrm((DEPTH, CONV_K, CONV_WIDTH), CONV_K ** -0.5),
        'd_conv_b': nrm((DEPTH, CONV_WIDTH), 0.01),
        'd_ln_g': 1.0 + nrm((DEPTH, CONV_WIDTH), 0.05),
        'd_ln_b': nrm((DEPTH, CONV_WIDTH), 0.01),
        'w_branch': nrm((DEPTH, N_BRANCH, MIX_WIDTH, Dm), MIX_WIDTH ** -0.5),
        'w_out': nrm((DEPTH, Dm, Dm), Dm ** -0.5),
        'mlp_w1': nrm((DEPTH, Dm, D_FF), Dm ** -0.5),
        'mlp_w2': nrm((DEPTH, D_FF, Dm), D_FF ** -0.5),
        'final_g': 1.0 + nrm((Dm,), 0.05),
    }


def reference(x, c, ctx, c_ctx, ada_w, ada_b, norm1_g, norm2_g, w_in, a_sink, s5_a_re, s5_a_im, s5_log_step,
              s5_b_re, s5_b_im, s5_c_re, s5_c_im, s5_d, s5_glu_w, s5_glu_b, c_rpb, d_conv_w, d_conv_b,
              d_ln_g, d_ln_b, w_branch, w_out, mlp_w1, mlp_w2, final_g):
    L = x.shape[1]
    rows = L // GRID_W
    t = jnp.arange(L)
    freqs = ROPE_BASE ** (-jnp.arange(ROPE_PAIRS, dtype=jnp.float32) / ROPE_PAIRS)
    ang = jnp.stack([(t // GRID_W).astype(jnp.float32)[:, None] * freqs,
                     (t % GRID_W).astype(jnp.float32)[:, None] * freqs], axis=1)
    cos, sin = jnp.cos(ang), jnp.sin(ang)
    z = ctx
    for l in range(DEPTH):
        need_ctx = l < DEPTH - 1
        mod_x = jnp.split((jax.nn.silu(c) @ ada_w[l] + ada_b[l])[:, None, :], 6, axis=-1)
        mod_z = jnp.split(jax.nn.silu(c_ctx) @ ada_w[l] + ada_b[l], 6, axis=-1)
        hx = modulate(rms_norm(x, norm1_g[l]), mod_x[0], mod_x[1])
        hz = modulate(rms_norm(z, norm1_g[l]), mod_z[0], mod_z[1])
        yx, yz = hybrid_mixer(hx, hz, cos, sin, rows, w_in[l], a_sink[l], s5_a_re[l], s5_a_im[l], s5_log_step[l],
                              s5_b_re[l], s5_b_im[l], s5_c_re[l], s5_c_im[l], s5_d[l], s5_glu_w[l], s5_glu_b[l],
                              c_rpb[l], d_conv_w[l], d_conv_b[l], d_ln_g[l], d_ln_b[l], w_branch[l], w_out[l],
                              need_ctx)
        x = x + mod_x[2] * yx
        x = x + mod_x[5] * squared_relu_mlp(modulate(rms_norm(x, norm2_g[l]), mod_x[3], mod_x[4]),
                                            mlp_w1[l], mlp_w2[l])
        if need_ctx:
            z = z + mod_z[2] * yz
            z = z + mod_z[5] * squared_relu_mlp(modulate(rms_norm(z, norm2_g[l]), mod_z[3], mod_z[4]),
                                                mlp_w1[l], mlp_w2[l])
    return rms_norm(x, final_g)
```

```cpp
#include <hip/hip_runtime.h>
#include <hip/hip_cooperative_groups.h>
#include <cstdio>
#include <cstdint>
namespace pg8 {
#define PG8_LAS __attribute__((address_space(3)))
typedef unsigned short bf16_t;
typedef short bf16x8 __attribute__((ext_vector_type(8)));
typedef float f32x4 __attribute__((ext_vector_type(4)));
typedef unsigned u32x4 __attribute__((ext_vector_type(4)));
constexpr int BM = 256, BK = 64, HALF = 128, HTB = HALF * BK * 2  , STAGE_BYTES = 8 * HTB, NXCD = 8, WGM = 8;

__host__ __device__ __forceinline__ int lds_byte(int r, int c) { const int st = (r >> 4) * 2 + (c >> 5), rr = r & 15, cc = c & 31, ob = rr * 64 + cc * 2; return st * 1024 + (ob ^ (((ob >> 9) & 1) << 5)); }
__host__ __device__ __forceinline__ void stage_rc(int b, int& R, int& C) { const int st = b / 1024, sb = b % 1024, swz = sb ^ (((sb >> 9) & 1) << 5); R = (st >> 1) * 16 + swz / 64; C = (st & 1) * 32 + (swz % 64) / 2; }
__host__ __device__ __forceinline__ int perm32(int rho) { const int n = rho >> 4, i = rho & 15; return 8 * (i >> 2) + 4 * n + (i & 3); }

struct Unit { int pm, pn, kn; __host__ __device__ int kofs() const { return kn & 0xffff; } __host__ __device__ int nt() const { return kn >> 16; } };
struct Gemm { const bf16_t* A; const bf16_t* Bt; int M, N, K, lda, ldb; };

struct StaticOrder {
    int nM, nN, nwg, G, c, ntk, zS, ntot;
    __host__ __device__ void init(int M, int N, int K, int G_, int c_, int zS_) { nM = M / BM; nN = N / BM; nwg = nM * nN; G = G_; c = c_; ntk = K / BK; zS = zS_; ntot = nwg + nN * zS_; }
    __host__ __device__ bool next(int i, Unit& u) const {
        const long L = (long)i * G + c; if (L >= ntot) return false;
        if (L >= nwg) { const int j = (int)L - nwg; u.pm = nM; u.pn = j % nN; { const int nt_ = ntk / zS; u.kn = (nt_ << 16) | ((j / nN) * nt_ * BK); } return true; }
        int wgid = (int)L; { const int q = nwg / NXCD, r = nwg % NXCD, xcd = wgid % NXCD, off = wgid / NXCD; wgid = (xcd < r ? xcd * (q + 1) : r * (q + 1) + (xcd - r) * q) + off; }
        const int nig = WGM * nN, gid = wgid / nig, fm = gid * WGM, gsz = (nM - fm) < WGM ? (nM - fm) : WGM;
        u.pm = fm + ((wgid % nig) % gsz); u.pn = (wgid % nig) / gsz; u.kn = ntk << 16; return true;
    }
    __device__ __forceinline__ void a_ready(const Unit&) const {}
    __device__ __forceinline__ void done(const Unit&) const {}
};

__device__ __forceinline__ unsigned cvt_pk_bf16(float lo, float hi) { unsigned r; asm volatile("v_cvt_pk_bf16_f32 %0, %1, %2" : "=v"(r) : "v"(lo), "v"(hi)); return r; }
typedef float f32x2 __attribute__((ext_vector_type(2)));
template <class Epi, class Sched, bool ALIGN_EPI = false, bool SP2 = false>
__device__ __forceinline__ void gemm_phase(PG8_LAS unsigned char* lds, const Gemm g, const Sched& S, const Epi& E) {
    int tid_l = threadIdx.x; asm volatile("" : "+v"(tid_l));
    const int tid = tid_l, wid = __builtin_amdgcn_readfirstlane(tid >> 6), lane = tid & 63, wr = wid >> 2, wc = wid & 3, fr = lane & 15, fq = lane >> 4;
    unsigned voffA[2], voffB[2];
#pragma unroll
    for (int i = 0; i < 2; ++i) { int R, C; stage_rc(tid * 16 + i * 8192, R, C); const int Rb = Epi::PERM ? ((R & ~31) + perm32(R & 31)) : R;
        voffA[i] = (unsigned)(R * g.lda + C) * 2u; voffB[i] = (unsigned)(Rb * g.ldb + C) * 2u; }
    const size_t kstep = (size_t)(BK * 2);
    const unsigned hstepA = (unsigned)(HALF * g.lda * 2), hstepB = (unsigned)(HALF * g.ldb * 2);
    const unsigned ldsw = (unsigned)wid * 1024u;
    const int aoff = lds_byte(wr * 64 + fr, fq * 8), boff = lds_byte(wc * 32 + fr, fq * 8);
#define PG8_SA(b, h) (((b) * 2 + (h)) * HTB)
#define PG8_SB(b, h) ((4 + (b) * 2 + (h)) * HTB)
#define PG8_STAGE(bufoff, gbase, voff) do { _Pragma("unroll") for (int _i = 0; _i < 2; ++_i) \
        __builtin_amdgcn_global_load_lds((const unsigned*)((const char*)(gbase) + (voff)[_i]), (PG8_LAS unsigned*)(lds + (bufoff) + ldsw + _i * 8192), 16, 0, 0); } while (0)
#define PG8_LDA(dst, b, h) do { _Pragma("unroll") for (int m = 0; m < 4; ++m) _Pragma("unroll") for (int k = 0; k < 2; ++k) dst[m][k] = *(const PG8_LAS bf16x8*)(lds + PG8_SA(b, h) + aoff + m * 2048 + k * 1024); } while (0)
#define PG8_LDB(dst, b, h) do { _Pragma("unroll") for (int n = 0; n < 2; ++n) _Pragma("unroll") for (int k = 0; k < 2; ++k) dst[n][k] = *(const PG8_LAS bf16x8*)(lds + PG8_SB(b, h) + boff + n * 2048 + k * 1024); } while (0)
#define PG8_MMA(ai, bj, At, Bt) do { __builtin_amdgcn_s_setprio(1); _Pragma("unroll") for (int m = 0; m < 4; ++m) _Pragma("unroll") for (int n = 0; n < 2; ++n) _Pragma("unroll") for (int k = 0; k < 2; ++k) \
        acc[ai][bj][m][n] = __builtin_amdgcn_mfma_f32_16x16x32_bf16(Bt[n][k], At[m][k], acc[ai][bj][m][n], 0, 0, 0); __builtin_amdgcn_s_setprio(0); } while (0)
#define PG8_WAIT_V(n) asm volatile("s_waitcnt vmcnt(" #n ")" ::: "memory")
#define PG8_WAIT_L(n) asm volatile("s_waitcnt lgkmcnt(" #n ")" ::: "memory")
#define PG8_BAR __builtin_amdgcn_s_barrier()
#define PG8_SCHED __builtin_amdgcn_sched_barrier(0)
    Unit cur, nxt; int ui = 0;
    if (!S.next(0, cur)) return;
    f32x4 acc[2][2][4][2];
#pragma unroll
    for (int a = 0; a < 2; ++a)
#pragma unroll
        for (int b = 0; b < 2; ++b)
#pragma unroll
            for (int m = 0; m < 4; ++m)
#pragma unroll
                for (int n = 0; n < 2; ++n) acc[a][b][m][n] = (f32x4){0.f, 0.f, 0.f, 0.f};
    bf16x8 At[4][2], B0[2][2], B1[2][2];
    const char* cA = (const char*)g.A + (size_t)cur.pm * (2 * hstepA) + (size_t)cur.kofs() * 2; const char* cB = (const char*)g.Bt + (size_t)cur.pn * (2 * hstepB) + (size_t)cur.kofs() * 2;
    S.a_ready(cur);
    if constexpr (SP2) {
        PG8_STAGE(PG8_SB(0, 0), cB, voffB); PG8_STAGE(PG8_SB(0, 1), cB + hstepB, voffB); PG8_STAGE(PG8_SA(0, 0), cA, voffA); PG8_STAGE(PG8_SA(0, 1), cA + hstepA, voffA);
        if (wr == 1) PG8_BAR;
        PG8_WAIT_V(2); PG8_BAR;
        PG8_STAGE(PG8_SB(1, 0), cB + kstep, voffB); PG8_STAGE(PG8_SA(1, 0), cA + kstep, voffA); PG8_STAGE(PG8_SB(1, 1), cB + hstepB + kstep, voffB);
        PG8_WAIT_V(6); PG8_BAR;
    } else {
        PG8_STAGE(PG8_SB(0, 0), cB, voffB); PG8_STAGE(PG8_SA(0, 0), cA, voffA); PG8_STAGE(PG8_SB(0, 1), cB + hstepB, voffB); PG8_STAGE(PG8_SA(0, 1), cA + hstepA, voffA);
        if (wr == 1) PG8_BAR;
        PG8_WAIT_V(4); PG8_BAR;
        PG8_STAGE(PG8_SB(1, 0), cB + kstep, voffB); PG8_STAGE(PG8_SA(1, 0), cA + kstep, voffA); PG8_STAGE(PG8_SB(1, 1), cB + hstepB + kstep, voffB);
        PG8_WAIT_V(6); PG8_BAR;
    }
    for (;;) {
        const bool has_next = S.next(ui + 1, nxt);
        const char* nA = has_next ? (const char*)g.A + (size_t)nxt.pm * (2 * hstepA) + (size_t)nxt.kofs() * 2 : cA; const char* nB = has_next ? (const char*)g.Bt + (size_t)nxt.pn * (2 * hstepB) + (size_t)nxt.kofs() * 2 : cB;
        const int nt = cur.nt();
        for (int t = 0; t < nt; t += 2) {
            const bool last = (t == nt - 2);
            const char* a1 = cA + (size_t)(t + 1) * kstep;
            const char* a2 = last ? nA : cA + (size_t)(t + 2) * kstep; const char* b2 = last ? nB : cB + (size_t)(t + 2) * kstep;
            const char* a3 = a2 + kstep; const char* b3 = b2 + kstep;
            if (last && has_next) S.a_ready(nxt);
            if constexpr (SP2) {
            PG8_LDB(B0, 0, 0); PG8_LDB(B1, 0, 1); PG8_SCHED; PG8_LDA(At, 0, 0); PG8_STAGE(PG8_SA(1, 1), a1 + hstepA, voffA);
            PG8_WAIT_V(8); PG8_WAIT_L(0); PG8_BAR; PG8_MMA(0, 0, At, B0); PG8_MMA(0, 1, At, B1); PG8_BAR; PG8_SCHED;
            PG8_LDA(At, 0, 1); PG8_STAGE(PG8_SB(0, 0), b2, voffB); PG8_STAGE(PG8_SB(0, 1), b2 + hstepB, voffB); PG8_STAGE(PG8_SA(0, 0), a2, voffA);
            PG8_WAIT_V(8); PG8_WAIT_L(0); PG8_BAR; PG8_MMA(1, 0, At, B0); PG8_MMA(1, 1, At, B1); PG8_BAR; PG8_SCHED;
            PG8_LDB(B0, 1, 0); PG8_LDB(B1, 1, 1); PG8_SCHED; PG8_LDA(At, 1, 0); PG8_STAGE(PG8_SA(0, 1), a2 + hstepA, voffA);
            PG8_WAIT_V(8); PG8_WAIT_L(0); PG8_BAR; PG8_MMA(0, 0, At, B0); PG8_MMA(0, 1, At, B1); PG8_BAR; PG8_SCHED;
            PG8_LDA(At, 1, 1); PG8_STAGE(PG8_SB(1, 0), b3, voffB); PG8_STAGE(PG8_SB(1, 1), b3 + hstepB, voffB); PG8_STAGE(PG8_SA(1, 0), a3, voffA);
            PG8_WAIT_V(8); PG8_WAIT_L(0); PG8_BAR; PG8_MMA(1, 0, At, B0); PG8_MMA(1, 1, At, B1); PG8_BAR; PG8_SCHED;
            } else {
            PG8_LDB(B0, 0, 0); PG8_SCHED; PG8_LDA(At, 0, 0); PG8_STAGE(PG8_SA(1, 1), a1 + hstepA, voffA);
            PG8_WAIT_L(8); PG8_BAR; PG8_WAIT_L(0); PG8_MMA(0, 0, At, B0); PG8_BAR; PG8_SCHED;
            PG8_LDB(B1, 0, 1); PG8_STAGE(PG8_SB(0, 0), b2, voffB);
            PG8_BAR; PG8_WAIT_L(0); PG8_MMA(0, 1, At, B1); PG8_BAR;
            PG8_LDA(At, 0, 1); PG8_STAGE(PG8_SA(0, 0), a2, voffA);
            PG8_BAR; PG8_WAIT_L(0); PG8_MMA(1, 0, At, B0); PG8_BAR; PG8_SCHED;
            PG8_STAGE(PG8_SB(0, 1), b2 + hstepB, voffB);
            PG8_WAIT_V(6); PG8_BAR; PG8_MMA(1, 1, At, B1); PG8_BAR;
            PG8_LDB(B0, 1, 0); PG8_SCHED; PG8_LDA(At, 1, 0); PG8_STAGE(PG8_SA(0, 1), a2 + hstepA, voffA);
            PG8_WAIT_L(8); PG8_BAR; PG8_WAIT_L(0); PG8_MMA(0, 0, At, B0); PG8_BAR; PG8_SCHED;
            PG8_LDB(B1, 1, 1); PG8_STAGE(PG8_SB(1, 0), b3, voffB);
            PG8_BAR; PG8_WAIT_L(0); PG8_MMA(0, 1, At, B1); PG8_BAR;
            PG8_LDA(At, 1, 1); PG8_STAGE(PG8_SA(1, 0), a3, voffA);
            PG8_BAR; PG8_WAIT_L(0); PG8_MMA(1, 0, At, B0); PG8_BAR; PG8_SCHED;
            PG8_STAGE(PG8_SB(1, 1), b3 + hstepB, voffB);
            PG8_WAIT_V(6); PG8_BAR; PG8_MMA(1, 1, At, B1); PG8_BAR;
            }
            if constexpr (Epi::HAS_MID) { if (((t + 2) & 7) == 0 && t + 2 < nt) E.mid(acc, cur, (t + 2) >> 3, wr, wc, fr, fq); }
        }
        if constexpr (ALIGN_EPI) { if (wr == 0) PG8_BAR; }
        if constexpr (!Epi::AFTER_DRAIN) { E(acc, cur, wr, wc, fr, fq); S.done(cur); }
        if (!has_next) break;
#pragma unroll
        for (int a = 0; a < 2; ++a)
#pragma unroll
            for (int b = 0; b < 2; ++b)
#pragma unroll
                for (int m = 0; m < 4; ++m)
#pragma unroll
                    for (int n = 0; n < 2; ++n) acc[a][b][m][n] = (f32x4){0.f, 0.f, 0.f, 0.f};
        cur = nxt; cA = nA; cB = nB; ++ui;
        if constexpr (ALIGN_EPI) { if (wr == 1) PG8_BAR; }
    }
    PG8_WAIT_V(0);
    if constexpr (!ALIGN_EPI) { if (wr == 0) PG8_BAR; }
    PG8_BAR;
    if constexpr (Epi::AFTER_DRAIN) { E.fused(acc, cur, wr, wc, fr, fq, lds, wid, lane); S.done(cur); }
#undef PG8_SA
#undef PG8_SB
#undef PG8_STAGE
#undef PG8_LDA
#undef PG8_LDB
#undef PG8_MMA
#undef PG8_WAIT_V
#undef PG8_WAIT_L
#undef PG8_BAR
#undef PG8_SCHED
}
}

namespace cg = cooperative_groups;
#ifndef GEMM_MASK
#define GEMM_MASK 0xff
#endif
#ifndef REP_P0
#define REP_P0 1
#endif
#ifndef REP_NORM
#define REP_NORM 1
#endif
#ifndef REP_MIXA
#define REP_MIXA 1
#endif
#ifndef REP_MIXB
#define REP_MIXB 1
#endif
#ifndef REP_MIXC
#define REP_MIXC 1
#endif
#ifndef REP_G1
#define REP_G1 1
#endif
#ifndef REP_G3
#define REP_G3 1
#endif
#ifndef REP_G5
#define REP_G5 1
#endif
#ifndef REP_SYNC
#define REP_SYNC 1
#endif
#ifndef REP_G6
#define REP_G6 1
#endif
#ifndef REP_CW1
#define REP_CW1 1
#endif
#ifndef REP_G4
#define REP_G4 1
#endif
#ifndef REP_CONV
#define REP_CONV 1
#endif
#ifndef REP_ATTA
#define REP_ATTA 1
#endif
#ifndef REP_ATTC
#define REP_ATTC 1
#endif
#ifndef REP_S51
#define REP_S51 1
#endif
#define DEV __device__ __forceinline__
#define LAS __attribute__((address_space(3)))
typedef unsigned short bf16;
typedef short bf16x8 __attribute__((ext_vector_type(8)));
typedef float f32x4 __attribute__((ext_vector_type(4)));
typedef float f32x2 __attribute__((ext_vector_type(2)));
typedef unsigned u32x4 __attribute__((ext_vector_type(4)));
typedef unsigned u32x2 __attribute__((ext_vector_type(2)));
using pg8::Unit;

constexpr int L = 16384, LC = 256, MT = L + LC, DM = 2048, NIN = 12032, NPA = 3840, NPG = 8192, DFF = 8192, MW = 512;
constexpr int NWAVES = 8, NTHR = 512;
constexpr int LDS_BYTES = 147456;
constexpr size_t MiB = 1u << 20;
constexpr size_t WS_MODV = 0, WS_ROPE = 256 * 1024, WS_BAR = 512 * 1024, WS_MODP = 1 * MiB;
constexpr int LDS_CTL = 131072 + 1024;
constexpr size_t WS_WIN = 8 * MiB, WS_WGLU = 55 * MiB, WS_WBR = 56 * MiB, WS_WOUT = 64 * MiB, WS_W1 = 72 * MiB, WS_W2 = 104 * MiB;
constexpr size_t WS_Z = 136 * MiB, WS_H = 138 * MiB, WS_PA = 203 * MiB, WS_PG = 333 * MiB, WS_Y = 593 * MiB;
constexpr size_t WS_OUTF = 658 * MiB, WS_OUTB = WS_OUTF + (size_t)MT * MW * 4, WS_G = 723 * MiB, WS_HEND = 740 * MiB, WS_VTA = 749 * MiB, WS_VTC = 754 * MiB, WS_KA = 771 * MiB, WS_KC = 776 * MiB, WS_END = 793 * MiB;
static_assert(WS_OUTB + (size_t)MT * MW * 4 <= WS_G && WS_G + (size_t)MT * MW * 2 <= WS_HEND && WS_VTC + (size_t)512 * MT * 2 <= WS_END, "ws map");
static_assert(WS_PA + (size_t)MT * DM * 4 <= WS_PG && WS_PG + (size_t)MT * NPG * 2 <= WS_Y && WS_Y + (size_t)MT * DM * 2 <= WS_OUTF, "ws map 2");

typedef __bf16 bf16x2_t __attribute__((ext_vector_type(2)));
DEV unsigned cvtpk(float lo, float hi) { f32x2 v = {lo, hi}; bf16x2_t b = __builtin_convertvector(v, bf16x2_t); return __builtin_bit_cast(unsigned, b); }
DEV float bflo(unsigned w) { return __uint_as_float(w << 16); }
DEV float bfhi(unsigned w) { return __uint_as_float(w & 0xffff0000u); }
DEV float bf2f(bf16 b) { return __uint_as_float((unsigned)b << 16); }
DEV bf16 f2bf1(float f) { return (bf16)(cvtpk(f, 0.f) & 0xffffu); }
DEV float sigmoidf_(float x) { return __builtin_amdgcn_rcpf(1.0f + __expf(-x)); }
DEV float wave_sum(float v) {
#pragma unroll
    for (int o = 1; o < 64; o <<= 1) v += __shfl_xor(v, o);
    return v;
}
DEV void unpack8(u32x4 w, float (&v)[8]) { v[0] = bflo(w.x); v[1] = bfhi(w.x); v[2] = bflo(w.y); v[3] = bfhi(w.y); v[4] = bflo(w.z); v[5] = bfhi(w.z); v[6] = bflo(w.w); v[7] = bfhi(w.w); }
DEV u32x4 pack8(const float (&v)[8]) { u32x4 w; w.x = cvtpk(v[0], v[1]); w.y = cvtpk(v[2], v[3]); w.z = cvtpk(v[4], v[5]); w.w = cvtpk(v[6], v[7]); return w; }

DEV void zp_store(const f32x4 (&acc)[2][2][4][2], const Unit& u, int wr, int wc, int fr, int fq, float* zp, int ncols) {
    const int row0 = wr * 64 + fr, col0 = u.pn * 256 + wc * 32 + 8 * fq, ks = u.kofs() / (u.nt() * 64);
#pragma unroll
    for (int ai = 0; ai < 2; ++ai)
#pragma unroll
        for (int m = 0; m < 4; ++m) { float* rp = zp + ((size_t)ks * 256 + row0 + ai * 128 + m * 16) * ncols + col0;
#pragma unroll
            for (int bj = 0; bj < 2; ++bj) { *(f32x4*)(rp + bj * 128) = acc[ai][bj][m][0]; *(f32x4*)(rp + bj * 128 + 4) = acc[ai][bj][m][1]; } }
}
struct EpiIn {
    static constexpr bool PERM = true, AFTER_DRAIN = false, HAS_MID = false;
    unsigned char* ws;
    DEV void operator()(const f32x4 (&acc)[2][2][4][2], const Unit& u, int wr, int wc, int fr, int fq) const {
        bf16* const PA = (bf16*)(ws + WS_PA); bf16* const PG = (bf16*)(ws + WS_PG); bf16* const VTA = (bf16*)(ws + WS_VTA); bf16* const VTC = (bf16*)(ws + WS_VTC); bf16* const KA = (bf16*)(ws + WS_KA); bf16* const KC = (bf16*)(ws + WS_KC); const f32x2* const rope = (const f32x2*)(ws + WS_ROPE);
        const int row0 = u.pm * 256 + wr * 64 + fr, ct = wc * 32 + 8 * fq;
        if (u.pn >= 15) {
            const int colb = (u.pn - 15) * 256 + ct;
#pragma unroll
            for (int ai = 0; ai < 2; ++ai)
#pragma unroll
                for (int m = 0; m < 4; ++m) { bf16* rowp = PG + (size_t)(row0 + ai * 128 + m * 16) * NPG + colb;
#pragma unroll
                    for (int bj = 0; bj < 2; ++bj) { float v[8];
#pragma unroll
                        for (int e = 0; e < 4; ++e) { v[e] = sigmoidf_(acc[ai][bj][m][0][e]); v[4 + e] = sigmoidf_(acc[ai][bj][m][1][e]); }
                        *(u32x4*)(rowp + bj * 128) = pack8(v); } }
        } else {
            const bool ropeu = (u.pn <= 2) && (u.pm < 64);
            const int colb = u.pn * 256 + ct;
            const float sgn = (fq >> 1) ? 1.f : -1.f;
#pragma unroll
            for (int ai = 0; ai < 2; ++ai)
#pragma unroll
                for (int m = 0; m < 4; ++m) { const int row = row0 + ai * 128 + m * 16; bf16* rowp = PA + (size_t)row * NPA + colb;
#pragma unroll
                    for (int bj = 0; bj < 2; ++bj) { float v[8];
#pragma unroll
                        for (int e = 0; e < 4; ++e) { v[e] = acc[ai][bj][m][0][e]; v[4 + e] = acc[ai][bj][m][1][e]; }
                        if (ropeu && !(u.pn == 2 && bj == 1)) {
                            const int pos = (wc & 1) ? (row & 63) : (row >> 6);
                            const f32x2* tab = rope + pos * 16 + 8 * (fq & 1);
#pragma unroll
                            for (int e = 0; e < 8; ++e) { const float pv = __shfl_xor(v[e], 32); const f32x2 cs = tab[e]; v[e] = v[e] * cs.x + sgn * pv * cs.y; }
                        }
                        const u32x4 pw = pack8(v);
                        *(u32x4*)(rowp + bj * 128) = pw;
                        if (u.pn == 2) { const int hk = ct >> 6, d0 = ct & 63;
                            if (bj == 0) *(u32x4*)(KA + ((size_t)hk * MT + row) * 64 + d0) = pw;
                            else { bf16* vp = VTA + (((size_t)hk * (MT / 16) + (row >> 4)) * 64 + d0) * 16 + (row & 15);
#pragma unroll
                                for (int e = 0; e < 8; ++e) vp[e * 16] = f2bf1(v[e]); } }
                        if (u.pn == 7 || u.pn == 8) { const int cv = (u.pn - 7) * 256 + bj * 128 + ct, hh = cv >> 6, d0 = cv & 63;
                            *(u32x4*)(KC + ((size_t)hh * MT + row) * 64 + d0) = pw; }
                        if (u.pn == 9 || u.pn == 10) { const int cv = (u.pn - 9) * 256 + bj * 128 + ct, hh = cv >> 6, d0 = cv & 63;
                            bf16* vp = VTC + (((size_t)hh * (MT / 16) + (row >> 4)) * 64 + d0) * 16 + (row & 15);
#pragma unroll
                            for (int e = 0; e < 8; ++e) vp[e * 16] = f2bf1(v[e]); }
                    } }
        }
    }
};
struct EpiGlu {
    static constexpr bool PERM = true, AFTER_DRAIN = false, HAS_MID = false;
    unsigned char* ws; const float* bias;
    DEV void operator()(const f32x4 (&acc)[2][2][4][2], const Unit& u, int wr, int wc, int fr, int fq) const {
        const bf16* const G = (const bf16*)(ws + WS_G); bf16* const Y = (bf16*)(ws + WS_Y);
        const int row0 = u.pm * 256 + wr * 64 + fr, col0 = u.pn * 256 + wc * 32 + 8 * fq;
        f32x4 bb[2][2];
#pragma unroll
        for (int bj = 0; bj < 2; ++bj) { bb[bj][0] = *(const f32x4*)(bias + col0 + bj * 128); bb[bj][1] = *(const f32x4*)(bias + col0 + bj * 128 + 4); }
#pragma unroll
        for (int ai = 0; ai < 2; ++ai) { u32x4 gw_[4][2];
#pragma unroll
            for (int m = 0; m < 4; ++m)
#pragma unroll
                for (int bj = 0; bj < 2; ++bj) gw_[m][bj] = *(const u32x4*)(G + (size_t)(row0 + ai * 128 + m * 16) * MW + col0 + bj * 128);
            asm volatile("" ::: "memory");
#pragma unroll
            for (int m = 0; m < 4; ++m) { const int row = row0 + ai * 128 + m * 16;
#pragma unroll
                for (int bj = 0; bj < 2; ++bj) { float g[8], v[8]; unpack8(gw_[m][bj], g);
#pragma unroll
                    for (int e = 0; e < 4; ++e) { v[e] = g[e] * sigmoidf_(acc[ai][bj][m][0][e] + bb[bj][0][e]); v[4 + e] = g[4 + e] * sigmoidf_(acc[ai][bj][m][1][e] + bb[bj][1][e]); }
                    *(u32x4*)(Y + (size_t)row * DM + 512 + col0 + bj * 128) = pack8(v); } } }
    }
};
struct EpiMerge {
    static constexpr bool PERM = true, AFTER_DRAIN = false, HAS_MID = true;
    unsigned char* ws;
    DEV void mid(f32x4 (&acc)[2][2][4][2], const Unit& u, int sec  , int wr, int wc, int fr, int fq) const {
        const bf16* const PG = (const bf16*)(ws + WS_PG);
        const int row0 = u.pm * 256 + wr * 64 + fr, col0 = u.pn * 256 + wc * 32 + 8 * fq;
        u32x4 w0[4][2], w1[4][2];
#pragma unroll
        for (int m = 0; m < 4; ++m) { const bf16* gp = PG + (size_t)(row0 + m * 16) * NPG + (sec - 1) * DM + col0;
#pragma unroll
            for (int bj = 0; bj < 2; ++bj) { w0[m][bj] = *(const u32x4*)(gp + bj * 128); w1[m][bj] = *(const u32x4*)(gp + DM + bj * 128); } }
#pragma unroll
        for (int ai = 0; ai < 2; ++ai)
#pragma unroll
            for (int m = 0; m < 4; ++m)
#pragma unroll
                for (int bj = 0; bj < 2; ++bj) { float g0[8], g1[8]; unpack8(w0[m][bj], g0); unpack8(w1[m][bj], g1);
                    if (ai == 0) { const bf16* gp = PG + (size_t)(row0 + 128 + m * 16) * NPG + (sec - 1) * DM + col0 + bj * 128; w0[m][bj] = *(const u32x4*)gp; w1[m][bj] = *(const u32x4*)(gp + DM); }
#pragma unroll
                    for (int e = 0; e < 4; ++e) { acc[ai][bj][m][0][e] *= g0[e] * __builtin_amdgcn_rcpf(fmaxf(g1[e], 1e-30f)); acc[ai][bj][m][1][e] *= g0[4 + e] * __builtin_amdgcn_rcpf(fmaxf(g1[4 + e], 1e-30f)); } }
    }
    DEV void operator()(const f32x4 (&acc)[2][2][4][2], const Unit& u, int wr, int wc, int fr, int fq) const {
        const bf16* const PG = (const bf16*)(ws + WS_PG); bf16* const Mb = (bf16*)(ws + WS_H);
        const int row0 = u.pm * 256 + wr * 64 + fr, col0 = u.pn * 256 + wc * 32 + 8 * fq;
#pragma unroll
        for (int ai = 0; ai < 2; ++ai) { u32x4 w3[4][2];
#pragma unroll
            for (int m = 0; m < 4; ++m)
#pragma unroll
                for (int bj = 0; bj < 2; ++bj) w3[m][bj] = *(const u32x4*)(PG + (size_t)(row0 + ai * 128 + m * 16) * NPG + 3 * DM + col0 + bj * 128);
            asm volatile("" ::: "memory");
#pragma unroll
            for (int m = 0; m < 4; ++m) { const int row = row0 + ai * 128 + m * 16;
#pragma unroll
                for (int bj = 0; bj < 2; ++bj) { float g[8], v[8]; unpack8(w3[m][bj], g);
#pragma unroll
                    for (int e = 0; e < 4; ++e) { v[e] = g[e] * acc[ai][bj][m][0][e]; v[4 + e] = g[4 + e] * acc[ai][bj][m][1][e]; }
                    *(u32x4*)(Mb + (size_t)row * DM + col0 + bj * 128) = pack8(v); } } }
    }
};
struct EpiRes {
    static constexpr bool PERM = true, AFTER_DRAIN = false, HAS_MID = false;
    const float* xsrc; float* xdst; float* zp; const float* gx;
    DEV void operator()(const f32x4 (&acc)[2][2][4][2], const Unit& u, int wr, int wc, int fr, int fq) const {
        if (u.pm >= 64) { zp_store(acc, u, wr, wc, fr, fq, zp, DM); return; }
        const int row0 = u.pm * 256 + wr * 64 + fr, col0 = u.pn * 256 + wc * 32 + 8 * fq;
        f32x4 gg[2][2];
#pragma unroll
        for (int bj = 0; bj < 2; ++bj) { gg[bj][0] = *(const f32x4*)(gx + col0 + bj * 128); gg[bj][1] = *(const f32x4*)(gx + col0 + bj * 128 + 4); }
#pragma unroll
        for (int ai = 0; ai < 2; ++ai) { f32x4 sv[4][2][2];
#pragma unroll
            for (int m = 0; m < 4; ++m) { const float* sp = xsrc + (size_t)(row0 + ai * 128 + m * 16) * DM + col0;
#pragma unroll
                for (int bj = 0; bj < 2; ++bj) { sv[m][bj][0] = *(const f32x4*)(sp + bj * 128); sv[m][bj][1] = *(const f32x4*)(sp + bj * 128 + 4); } }
            asm volatile("" ::: "memory");
#pragma unroll
            for (int m = 0; m < 4; ++m) { float* dp = xdst + (size_t)(row0 + ai * 128 + m * 16) * DM + col0;
#pragma unroll
                for (int bj = 0; bj < 2; ++bj) { *(f32x4*)(dp + bj * 128) = sv[m][bj][0] + gg[bj][0] * acc[ai][bj][m][0]; *(f32x4*)(dp + bj * 128 + 4) = sv[m][bj][1] + gg[bj][1] * acc[ai][bj][m][1]; } } }
    }
};
struct EpiRelu2 {
    static constexpr bool PERM = true, AFTER_DRAIN = false, HAS_MID = false;
    bf16* O; float* zp;
    DEV void operator()(const f32x4 (&acc)[2][2][4][2], const Unit& u, int wr, int wc, int fr, int fq) const {
        if (u.pm >= 64) { zp_store(acc, u, wr, wc, fr, fq, zp, DFF); return; }
        const int row0 = u.pm * 256 + wr * 64 + fr, col0 = u.pn * 256 + wc * 32 + 8 * fq;
#pragma unroll
        for (int ai = 0; ai < 2; ++ai)
#pragma unroll
            for (int m = 0; m < 4; ++m) { bf16* rowp = O + (size_t)(row0 + ai * 128 + m * 16) * DFF + col0;
#pragma unroll
                for (int bj = 0; bj < 2; ++bj) { float v[8];
#pragma unroll
                    for (int e = 0; e < 4; ++e) { float a = fmaxf(acc[ai][bj][m][0][e], 0.f), b = fmaxf(acc[ai][bj][m][1][e], 0.f); v[e] = a * a; v[4 + e] = b * b; }
                    *(u32x4*)(rowp + bj * 128) = pack8(v); } }
    }
};

#define XB_TMO      128
#define XB_XCNT(j)  (256  + 64 * (j))
#define XB_XSUB(j)  (1280 + 64 * (j))
#define XB_XGEN(j)  (2304 + 64 * (j))
#define XB_TOP      3328
#define XB_TOPGEN   3392
#define XCD_BAR_WORDS 3456
#define XB_SPIN_CAP (1u << 18)

__device__ __forceinline__ unsigned xb_ld(unsigned* p)              { return __hip_atomic_load(p, __ATOMIC_RELAXED, __HIP_MEMORY_SCOPE_AGENT); }
__device__ __forceinline__ unsigned xb_add(unsigned* p, unsigned v) { return __hip_atomic_fetch_add(p, v, __ATOMIC_RELAXED, __HIP_MEMORY_SCOPE_AGENT); }
__device__ __forceinline__ unsigned xb_xcc_id() { return (unsigned)__builtin_amdgcn_s_getreg((3 << 11) | 20) & 0xFu; }
#define XB_SPIN(cond, bar) do { unsigned _sp = 0; while (cond) { __builtin_amdgcn_s_sleep(1); \
    if ((++_sp & 255u) == 0u) { if (xb_ld(&(bar)[XB_TMO])) break; if (_sp > XB_SPIN_CAP) { atomicAdd(&(bar)[XB_TMO], 1u); break; } } } } while (0)

struct XcdBarrier {
    unsigned* bar; unsigned x;
    volatile LAS unsigned* st;
};

__device__ __forceinline__ XcdBarrier xcd_barrier_post(unsigned* bar, volatile LAS unsigned* st) {
    XcdBarrier b; b.bar = bar; b.x = xb_xcc_id(); b.st = st;
    if (threadIdx.x == 0) (void)xb_add(&bar[XB_XCNT(b.x)], 1u);
    return b;
}
__device__ __forceinline__ void xcd_barrier_complete(unsigned* bar, unsigned x, unsigned& nloc, unsigned& nx) {
    const unsigned G = gridDim.x * gridDim.y * gridDim.z;
    unsigned sum, cnt, mine, sp = 0u;
    for (;;) {
        sum = 0u; cnt = 0u; mine = 0u;
#pragma unroll
        for (unsigned j = 0; j < 16; ++j) { const unsigned c = xb_ld(&bar[XB_XCNT(j)]); sum += c; cnt += (c > 0u) ? 1u : 0u; mine = (j == x) ? c : mine; }
        if (sum == G) break;
        __builtin_amdgcn_s_sleep(1);
        if ((++sp & 255u) == 0u) { if (xb_ld(&bar[XB_TMO])) break; if (sp > XB_SPIN_CAP) { atomicAdd(&bar[XB_TMO], 1u); break; } }
    }
    nloc = mine > 0u ? mine : 1u; nx = cnt > 0u ? cnt : 1u;
}

__device__ __forceinline__ void xcd_barrier(const XcdBarrier& b) {
    asm volatile("s_waitcnt vmcnt(0)" ::: "memory");
    __syncthreads();
    if (threadIdx.x == 0) {
        unsigned* bar = b.bar;
        __builtin_amdgcn_s_waitcnt(0);
        unsigned nloc = b.st[0], nx = b.st[1];
        if (nloc == 0u) { xcd_barrier_complete(bar, b.x, nloc, nx); b.st[0] = nloc; b.st[1] = nx; }
        const unsigned old = xb_add(&bar[XB_XSUB(b.x)], 1u);
        const unsigned gen = old / nloc;
        if (old + 1u == (gen + 1u) * nloc) {
            __builtin_amdgcn_fence(__ATOMIC_RELEASE, "agent");
            asm volatile("s_waitcnt vmcnt(0)" ::: "memory");
            const unsigned og = xb_add(&bar[XB_TOP], 1u);
            const unsigned tg = og / nx;
            if (og + 1u == (tg + 1u) * nx) xb_add(&bar[XB_TOPGEN], 1u);
            else XB_SPIN(xb_ld(&bar[XB_TOPGEN]) == tg, bar);
            __builtin_amdgcn_fence(__ATOMIC_ACQUIRE, "agent");
            xb_add(&bar[XB_XGEN(b.x)], 1u);
            asm volatile("s_waitcnt vmcnt(0)" ::: "memory");
        } else {
            XB_SPIN(xb_ld(&bar[XB_XGEN(b.x)]) == gen, bar);
            __builtin_amdgcn_fence(__ATOMIC_ACQUIRE, "agent");
            asm volatile("s_waitcnt vmcnt(0)" ::: "memory");
        }
    }
    __syncthreads();
}
struct Args { const float* in[30]; float* out; unsigned char* ws; };
typedef const __attribute__((address_space(4))) Args* KA;
DEV KA kargs() { KA p = (KA)__builtin_amdgcn_kernarg_segment_ptr(); asm volatile("" : "+s"(p)); return p; }

DEV void transpose_item(const float* W, int K, int N, bf16* WT, LAS float* scr, int item, int lane, int ldw = 0) {
    if (ldw == 0) ldw = K;
    const int nblk = N / 32, kb = item / nblk, nb = item % nblk, k0 = 64 * kb, n0 = 32 * nb;
#pragma unroll 8
    for (int i = 0; i < 32; ++i) { const int kk = 2 * i + (lane >> 5); scr[kk * 33 + (lane & 31)] = W[(size_t)(k0 + kk) * N + n0 + (lane & 31)]; }
    asm volatile("s_waitcnt lgkmcnt(0)" ::: "memory");
    const int c = lane & 7;
#pragma unroll
    for (int j = 0; j < 4; ++j) { const int n = (lane >> 3) + 8 * j; const LAS float* s = scr + (8 * c) * 33 + n;
        u32x4 o; o.x = cvtpk(s[0 * 33], s[1 * 33]); o.y = cvtpk(s[2 * 33], s[3 * 33]); o.z = cvtpk(s[4 * 33], s[5 * 33]); o.w = cvtpk(s[6 * 33], s[7 * 33]);
        *(u32x4*)(WT + (size_t)(n0 + n) * ldw + k0 + 8 * c) = o; }
    asm volatile("s_waitcnt lgkmcnt(0)" ::: "memory");
}
DEV void convert_weights(KA a, int l, LAS unsigned char* lds, int gw, int NGW, int wave, int lane, int part  ) {
    LAS float* scr = (LAS float*)(lds + wave * 16384);
    unsigned char* ws = a->ws;
    constexpr int I_IN = 32 * 376, I_GLU = 8 * 16, I_BR = 8 * 64, I_OUT = 32 * 64, I_1 = 32 * 256, I_2 = 128 * 64;
    constexpr int NITEMS = I_IN + I_GLU + 4 * I_BR + I_OUT + I_1 + I_2;
    const int it0 = (part == 2) ? I_IN : 0, it1 = (part == 1) ? I_IN : NITEMS;
    for (int it = it0 + gw; it < it1; it += NGW) {
        int r = it;
        if (r < I_IN) { transpose_item(a->in[8] + (size_t)l * DM * NIN, DM, NIN, (bf16*)(ws + WS_WIN), scr, r, lane); continue; } r -= I_IN;
        if (r < I_GLU) { transpose_item(a->in[18] + (size_t)l * MW * MW, MW, MW, (bf16*)(ws + WS_WGLU), scr, r, lane); continue; } r -= I_GLU;
        if (r < 4 * I_BR) { const int br = r / I_BR; transpose_item(a->in[25] + (size_t)(l * 4 + br) * MW * DM, MW, DM, (bf16*)(ws + WS_WBR) + (size_t)br * MW, scr, r % I_BR, lane, DM); continue; } r -= 4 * I_BR;
        if (r < I_OUT) { transpose_item(a->in[26] + (size_t)l * DM * DM, DM, DM, (bf16*)(ws + WS_WOUT), scr, r, lane); continue; } r -= I_OUT;
        if (r < I_1) { transpose_item(a->in[27] + (size_t)l * DM * DFF, DM, DFF, (bf16*)(ws + WS_W1), scr, r, lane); continue; } r -= I_1;
        transpose_item(a->in[28] + (size_t)l * DFF * DM, DFF, DM, (bf16*)(ws + WS_W2), scr, r, lane);
    }
}
DEV void modp_items(KA a, int gw, int NGW, int lane) {
    float* MODP = (float*)(a->ws + WS_MODP);
    for (int it = gw; it < 2 * 48 * 32; it += NGW) {
        const int l = it / (48 * 32), r = it % (48 * 32), cgp = r / 32, ks = r % 32;
        const float* W = a->in[4] + (size_t)l * DM * 12288 + (size_t)(64 * ks) * 12288 + 256 * cgp + 4 * lane;
        const float* cv = a->in[1] + 64 * ks; const float* cz = a->in[3] + 64 * ks;
        f32x4 ax = {0.f, 0.f, 0.f, 0.f}, az = {0.f, 0.f, 0.f, 0.f};
#pragma unroll 8
        for (int k = 0; k < 64; ++k) { const f32x4 w = *(const f32x4*)(W + (size_t)k * 12288); const float c1 = cv[k], c2 = cz[k];
            const float s1 = c1 * sigmoidf_(c1), s2 = c2 * sigmoidf_(c2); ax += w * s1; az += w * s2; }
        float* o = MODP + ((size_t)(l * 32 + ks) * 2) * 12288 + 256 * cgp + 4 * lane;
        *(f32x4*)o = ax; *(f32x4*)(o + 12288) = az;
    }
}
DEV void modv_reduce(KA a, int gtid, int NGT) {
    const float* MODP = (const float*)(a->ws + WS_MODP); float* MODV = (float*)(a->ws + WS_MODV);
    for (int i = gtid; i < 2 * 2 * 12288; i += NGT) { const int l = i / (2 * 12288), xz = (i / 12288) & 1, j = i % 12288;
        float s = a->in[5][l * 12288 + j];
        for (int ks = 0; ks < 32; ++ks) s += MODP[((size_t)(l * 32 + ks) * 2 + xz) * 12288 + j];
        MODV[i] = s; }
    f32x2* rope = (f32x2*)(a->ws + WS_ROPE);
    for (int i = gtid; i < 256 * 16; i += NGT) { const int pos = i >> 4, p = i & 15;
        const float freq = powf(10000.0f, -(float)p / 16.0f); const float ang = (float)pos * freq;
        rope[i] = (f32x2){cosf(ang), sinf(ang)}; }
}
DEV void norm_rows(const float* xsrc, const float* zsrc, const float* g, const float* modx, const float* modz, int ishift, int iscale, bf16* H, int nrows, int gw, int NGW, int lane,
                   const float* zp, int zS, const float* zgate, float* zdst) {
    for (int row = gw; row < nrows; row += NGW) {
        const bool isz = row >= L;
        const float* xr = isz ? zsrc + (size_t)(row - L) * DM : xsrc + (size_t)row * DM;
        const float* mod = isz ? modz : modx;
        f32x4 v[8]; float s = 0.f;
#pragma unroll
        for (int j = 0; j < 8; ++j) v[j] = *(const f32x4*)(xr + 4 * lane + 256 * j);
        if (isz && zp) {
#pragma unroll
            for (int j = 0; j < 8; ++j) { const int c = 4 * lane + 256 * j; f32x4 t = {0.f, 0.f, 0.f, 0.f};
                for (int ks = 0; ks < zS; ++ks) t += *(const f32x4*)(zp + ((size_t)ks * 256 + (row - L)) * DM + c);
                v[j] += *(const f32x4*)(zgate + c) * t; *(f32x4*)(zdst + (size_t)(row - L) * DM + c) = v[j]; } }
#pragma unroll
        for (int j = 0; j < 8; ++j) s += (v[j].x * v[j].x + v[j].y * v[j].y) + (v[j].z * v[j].z + v[j].w * v[j].w);
        const float rstd = 1.0f / sqrtf(wave_sum(s) * (1.0f / DM) + 1e-6f);
#pragma unroll
        for (int j = 0; j < 8; ++j) { const int c = 4 * lane + 256 * j;
            const f32x4 gg = *(const f32x4*)(g + c), sh = *(const f32x4*)(mod + ishift * DM + c), sc = *(const f32x4*)(mod + iscale * DM + c);
            const f32x4 y = (v[j] * rstd) * gg; const f32x4 h = y * (sc + 1.0f) + sh;
            u32x2 w; w.x = cvtpk(h.x, h.y); w.y = cvtpk(h.z, h.w); *(u32x2*)(H + (size_t)row * DM + c) = w; }
    }
}
DEV void zfin_relu2(const float* zp, int zS, bf16* HM, int gtid, int NGT) {
    for (int i = gtid; i < 256 * (DFF / 8); i += NGT) { const int r = i / (DFF / 8), c8 = (i % (DFF / 8)) * 8; f32x4 t0 = {0.f, 0.f, 0.f, 0.f}, t1 = {0.f, 0.f, 0.f, 0.f};
        for (int ks = 0; ks < zS; ++ks) { const float* p = zp + ((size_t)ks * 256 + r) * DFF + c8; t0 += *(const f32x4*)p; t1 += *(const f32x4*)(p + 4); }
        float v[8];
#pragma unroll
        for (int e = 0; e < 4; ++e) { const float a0 = fmaxf(t0[e], 0.f), a1 = fmaxf(t1[e], 0.f); v[e] = a0 * a0; v[4 + e] = a1 * a1; }
        *(u32x4*)(HM + (size_t)(L + r) * DFF + c8) = pack8(v); }
}
DEV void final_rows(float* x, const float* g, int gw, int NGW, int lane) {
    for (int row = gw; row < L; row += NGW) {
        float* xr = x + (size_t)row * DM; f32x4 v[8]; float s = 0.f;
#pragma unroll
        for (int j = 0; j < 8; ++j) { v[j] = *(const f32x4*)(xr + 4 * lane + 256 * j); s += (v[j].x * v[j].x + v[j].y * v[j].y) + (v[j].z * v[j].z + v[j].w * v[j].w); }
        const float rstd = 1.0f / sqrtf(wave_sum(s) * (1.0f / DM) + 1e-6f);
#pragma unroll
        for (int j = 0; j < 8; ++j) { const int c = 4 * lane + 256 * j; *(f32x4*)(xr + c) = (v[j] * rstd) * *(const f32x4*)(g + c); }
    }
}

struct AttnSt { f32x4 o[4]; float m, l; };
struct KVF { bf16x8 k[4]; u32x2 v[8]; };
DEV void k_load(KVF& f, const bf16* K, int bA, int bB, int fr, int g) {
    const unsigned lo = (unsigned)(fr * 64 + 8 * g);
    const bf16* ka = K + (size_t)__builtin_amdgcn_readfirstlane(bA) * 64; const bf16* kb = K + (size_t)__builtin_amdgcn_readfirstlane(bB) * 64;
    f.k[0] = *(const bf16x8*)(ka + lo); f.k[1] = *(const bf16x8*)(ka + lo + 32); f.k[2] = *(const bf16x8*)(kb + lo); f.k[3] = *(const bf16x8*)(kb + lo + 32);
}
DEV void v_load(KVF& f, const bf16* V, int bA, int bB, int fr, int g) {
    const unsigned lo = (unsigned)(fr * 16 + 4 * g);
    const bf16* va = V + (size_t)__builtin_amdgcn_readfirstlane(bA >> 4) * 1024; const bf16* vb = V + (size_t)__builtin_amdgcn_readfirstlane(bB >> 4) * 1024;
#pragma unroll
    for (int d = 0; d < 4; ++d) { f.v[d] = *(const u32x2*)(va + lo + d * 256); f.v[4 + d] = *(const u32x2*)(vb + lo + d * 256); }
}
DEV void kv_load(KVF& f, const bf16* K, const bf16* V, int bA, int bB, int fr, int g) { k_load(f, K, bA, bB, fr, g); v_load(f, V, bA, bB, fr, g); }
DEV void attn_compute(AttnSt& st, const bf16x8 q0, const bf16x8 q1, const KVF& f, f32x4 bA, f32x4 bB) {
    f32x4 sA = {0.f, 0.f, 0.f, 0.f}, sB = {0.f, 0.f, 0.f, 0.f};
    sA = __builtin_amdgcn_mfma_f32_16x16x32_bf16(f.k[0], q0, sA, 0, 0, 0); sA = __builtin_amdgcn_mfma_f32_16x16x32_bf16(f.k[1], q1, sA, 0, 0, 0);
    sB = __builtin_amdgcn_mfma_f32_16x16x32_bf16(f.k[2], q0, sB, 0, 0, 0); sB = __builtin_amdgcn_mfma_f32_16x16x32_bf16(f.k[3], q1, sB, 0, 0, 0);
    float tm = -1e30f;
#pragma unroll
    for (int i = 0; i < 4; ++i) { sA[i] = (bA[i] <= -1e29f) ? -1e30f : sA[i] * 0.125f + bA[i]; sB[i] = (bB[i] <= -1e29f) ? -1e30f : sB[i] * 0.125f + bB[i]; tm = fmaxf(tm, fmaxf(sA[i], sB[i])); }
    tm = fmaxf(tm, __shfl_xor(tm, 16)); tm = fmaxf(tm, __shfl_xor(tm, 32));
    const float mn = fmaxf(st.m, tm), alpha = __expf(st.m - mn); st.m = mn;
    float ps = 0.f; float pa[4], pb[4];
#pragma unroll
    for (int i = 0; i < 4; ++i) { pa[i] = __expf(sA[i] - mn); pb[i] = __expf(sB[i] - mn); ps += pa[i] + pb[i]; }
    st.l = st.l * alpha + ps;
    u32x4 pw; pw.x = cvtpk(pa[0], pa[1]); pw.y = cvtpk(pa[2], pa[3]); pw.z = cvtpk(pb[0], pb[1]); pw.w = cvtpk(pb[2], pb[3]);
    const bf16x8 pfrag = __builtin_bit_cast(bf16x8, pw);
#pragma unroll
    for (int d = 0; d < 4; ++d) { u32x4 vw; vw.x = f.v[d].x; vw.y = f.v[d].y; vw.z = f.v[4 + d].x; vw.w = f.v[4 + d].y;
        st.o[d] = st.o[d] * alpha; st.o[d] = __builtin_amdgcn_mfma_f32_16x16x32_bf16(__builtin_bit_cast(bf16x8, vw), pfrag, st.o[d], 0, 0, 0); }
}
DEV void attn_finish(const AttnSt& st, bf16* yrow  ) {
    float l = st.l; l += __shfl_xor(l, 16); l += __shfl_xor(l, 32);
    const float inv = 1.0f / l;
#pragma unroll
    for (int d = 0; d < 4; ++d) { u32x2 w; w.x = cvtpk(st.o[d][0] * inv, st.o[d][1] * inv); w.y = cvtpk(st.o[d][2] * inv, st.o[d][3] * inv); *(u32x2*)(yrow + 16 * d) = w; }
}
DEV void attnA_item(KA a, int l, int item, bool isctx, int lane) {
    const bf16* PA = (const bf16*)(a->ws + WS_PA); bf16* Y = (bf16*)(a->ws + WS_Y);
    const int fr = lane & 15, g = lane >> 4, hk = item & 1, qb = item >> 1, q0 = (isctx ? L : 0) + 16 * qb, qt = q0 + fr;
    const bf16* K = (const bf16*)(a->ws + WS_KA) + (size_t)hk * MT * 64; const bf16* V = (const bf16*)(a->ws + WS_VTA) + (size_t)hk * (MT / 16) * 1024;
    bf16x8 qf[4][2]; AttnSt st[4];
#pragma unroll
    for (int s = 0; s < 4; ++s) { const bf16* qp = PA + (size_t)qt * NPA + (hk * 4 + s) * 64 + 8 * g; qf[s][0] = *(const bf16x8*)qp; qf[s][1] = *(const bf16x8*)(qp + 32);
        st[s].m = a->in[9][l * 8 + hk * 4 + s]; st[s].l = (g == 0) ? 1.0f : 0.0f;
#pragma unroll
        for (int d = 0; d < 4; ++d) st[s].o[d] = (f32x4){0.f, 0.f, 0.f, 0.f}; }
    const int NP = isctx ? 8 : 17;
    KVF cur, nxt; kv_load(cur, K, V, L, L + 16, fr, g);
    for (int pi = 0; pi < NP; ++pi) {
        { const int pn = (pi + 1 < NP) ? pi + 1 : pi; int bA, bB;
          if (pn < 8) { bA = L + 32 * pn; bB = bA + 16; } else { bA = q0 - 128 + 32 * (pn - 8); bB = bA + 16; bA = (bA >= 0 && bA < L) ? bA : 0; bB = (bB >= 0 && bB < L) ? bB : 0; }
          kv_load(nxt, K, V, bA, bB, fr, g); }
        f32x4 m0 = {0.f, 0.f, 0.f, 0.f}, m1 = {0.f, 0.f, 0.f, 0.f};
        if (pi >= 8) { const int b0 = q0 - 128 + 32 * (pi - 8), b1 = b0 + 16; const bool ok0 = (b0 >= 0) && (b0 < L), ok1 = (b1 >= 0) && (b1 < L);
#pragma unroll
            for (int i = 0; i < 4; ++i) { const int d0 = b0 + 4 * g + i - qt, d1 = b1 + 4 * g + i - qt;
                m0[i] = (ok0 && d0 >= -128 && d0 <= 128) ? 0.f : -1e30f; m1[i] = (ok1 && d1 >= -128 && d1 <= 128) ? 0.f : -1e30f; } }
#pragma unroll
        for (int s = 0; s < 4; ++s) attn_compute(st[s], qf[s][0], qf[s][1], cur, m0, m1);
        cur = nxt;
    }
#pragma unroll
    for (int s = 0; s < 4; ++s) attn_finish(st[s], Y + (size_t)qt * DM + (hk * 4 + s) * 64 + 4 * g);
}
DEV void attnC_item(KA a, int l, int item, bool isctx, LAS float* rps, int lane) {
    const bf16* PA = (const bf16*)(a->ws + WS_PA); bf16* Y = (bf16*)(a->ws + WS_Y);
    const int fr = lane & 15, g = lane >> 4, h = item & 7, r = item >> 3, q0 = isctx ? L + 64 * r : 64 * r;
    const bf16* K = (const bf16*)(a->ws + WS_KC) + (size_t)h * MT * 64; const bf16* V = (const bf16*)(a->ws + WS_VTC) + (size_t)h * (MT / 16) * 1024;
    if (!isctx) { const float* rpb = a->in[20] + (size_t)(l * 8 + h) * 465; for (int i = lane; i < 465; i += 64) rps[i] = rpb[i]; }
    bf16x8 qf[4][2]; AttnSt st[4];
#pragma unroll
    for (int s = 0; s < 4; ++s) { const bf16* qp = PA + (size_t)(q0 + 16 * s + fr) * NPA + 1280 + h * 64 + 8 * g; qf[s][0] = *(const bf16x8*)qp; qf[s][1] = *(const bf16x8*)(qp + 32);
        st[s].m = -1e30f; st[s].l = 0.f;
#pragma unroll
        for (int d = 0; d < 4; ++d) st[s].o[d] = (f32x4){0.f, 0.f, 0.f, 0.f}; }
    const int krow0 = min(max(r - 4, 0), 248);
    KVF cur, nxt; kv_load(cur, K, V, L, L + 16, fr, g);
    for (int pi = 0; pi < 8; ++pi) {
        { int bA = (pi < 7) ? L + 32 * (pi + 1) : (isctx ? L : krow0 * 64); kv_load(nxt, K, V, bA, bA + 16, fr, g); }
        const f32x4 z = {0.f, 0.f, 0.f, 0.f};
#pragma unroll
        for (int s = 0; s < 4; ++s) attn_compute(st[s], qf[s][0], qf[s][1], cur, z, z);
        cur = nxt;
    }
    if (!isctx) {
#define C_MASKS(s, pp) const int qcol = 16 * (s) + fr, cstart = min(max(qcol - 8, 0), 48); f32x4 m0, m1; \
        _Pragma("unroll") for (int i = 0; i < 4; ++i) { const int kc0 = 32 * (pp) + 4 * g + i, kc1 = kc0 + 16; \
            m0[i] = (kc0 >= cstart && kc0 < cstart + 16) ? rp[kc0 - qcol + 15] : -1e30f; m1[i] = (kc1 >= cstart && kc1 < cstart + 16) ? rp[kc1 - qcol + 15] : -1e30f; }
        for (int i8 = 0; i8 < 8; ++i8) {
            const int krow = krow0 + i8; const LAS float* rp = rps + (krow - r + 7) * 31;
            k_load(nxt, K, krow * 64 + 32, krow * 64 + 48, fr, g);
#pragma unroll
            for (int s = 0; s < 3; ++s) { C_MASKS(s, 0) attn_compute(st[s], qf[s][0], qf[s][1], cur, m0, m1); }
            v_load(cur, V, krow * 64 + 32, krow * 64 + 48, fr, g);
#pragma unroll
            for (int q = 0; q < 4; ++q) cur.k[q] = nxt.k[q];
            { const int kn = (i8 < 7) ? krow + 1 : krow; k_load(nxt, K, kn * 64, kn * 64 + 16, fr, g); }
#pragma unroll
            for (int s = 1; s < 4; ++s) { C_MASKS(s, 1) attn_compute(st[s], qf[s][0], qf[s][1], cur, m0, m1); }
            { const int kn = (i8 < 7) ? krow + 1 : krow; v_load(cur, V, kn * 64, kn * 64 + 16, fr, g); }
#pragma unroll
            for (int q = 0; q < 4; ++q) cur.k[q] = nxt.k[q];
        }
#undef C_MASKS
    }
#pragma unroll
    for (int s = 0; s < 4; ++s) attn_finish(st[s], Y + (size_t)(q0 + 16 * s + fr) * DM + 1024 + h * 64 + 4 * g);
}

DEV void conv_item(KA a, int l, int item, LAS unsigned char* lds, int tid) {
    const bf16* PA = (const bf16*)(a->ws + WS_PA); bf16* Y = (bf16*)(a->ws + WS_Y);
    LAS float* hs = (LAS float*)lds;
    LAS float* ys = (LAS float*)(lds + 46 * 512 * 4);
    const bool isz = item >= L / 16; const int rowbase = isz ? L : 0, seqlen = isz ? LC : L, t0 = (isz ? item - L / 16 : item) * 16;
    for (int idx = tid; idx < 46 * 64; idx += NTHR) { const int tt = t0 - 15 + (idx >> 6), c8 = (idx & 63) * 8; float h[8];
        if (tt >= 0 && tt < seqlen) { float v[8], gt[8]; const bf16* p = PA + (size_t)(rowbase + tt) * NPA + 2816 + c8;
            unpack8(*(const u32x4*)p, v); unpack8(*(const u32x4*)(p + 512), gt);
#pragma unroll
            for (int e = 0; e < 8; ++e) h[e] = v[e] * sigmoidf_(gt[e]); }
        else {
#pragma unroll
            for (int e = 0; e < 8; ++e) h[e] = 0.f; }
        LAS float* d = hs + (idx >> 6) * 512 + c8; *(LAS f32x4*)d = (f32x4){h[0], h[1], h[2], h[3]}; *(LAS f32x4*)(d + 4) = (f32x4){h[4], h[5], h[6], h[7]}; }
    __syncthreads();
    { const int ch = tid; float w[31]; const float* wp = a->in[21] + (size_t)l * 31 * 512 + ch;
#pragma unroll
        for (int k = 0; k < 31; ++k) w[k] = wp[k * 512];
        const float b = a->in[22][l * 512 + ch];
        for (int tok = 0; tok < 16; ++tok) { float y = b;
#pragma unroll
            for (int k = 0; k < 31; ++k) y += hs[(tok + k) * 512 + ch] * w[k];
            ys[tok * 512 + ch] = y; } }
    __syncthreads();
    { const int wave = tid >> 6, lane = tid & 63;
        const float* lg = a->in[23] + l * 512; const float* lb = a->in[24] + l * 512;
        for (int tt = 0; tt < 2; ++tt) { const int tok = wave * 2 + tt; float y[8]; float s = 0.f;
#pragma unroll
            for (int j = 0; j < 8; ++j) { y[j] = ys[tok * 512 + lane + 64 * j]; s += y[j]; }
            const float mu = wave_sum(s) * (1.0f / 512.0f); float q = 0.f;
#pragma unroll
            for (int j = 0; j < 8; ++j) { y[j] -= mu; q += y[j] * y[j]; }
            const float rstd = 1.0f / sqrtf(wave_sum(q) * (1.0f / 512.0f) + 1e-6f);
            bf16* yr = Y + (size_t)(rowbase + t0 + tok) * DM + 1536;
#pragma unroll
            for (int j = 0; j < 8; ++j) { const int ch = lane + 64 * j; const float yn = y[j] * rstd * lg[ch] + lb[ch]; yr[ch] = f2bf1(yn * sigmoidf_(yn)); } } }
    __syncthreads();
}

DEV int s5_row(int dir, int s) { return dir == 0 ? (s < LC ? L + s : s - LC) : (MT - 1 - s); }
typedef short bf16x4 __attribute__((ext_vector_type(4)));
constexpr size_t WS_S5BB = WS_MODP, WS_S5AB = WS_MODP + 1 * MiB;
DEV void s5_tables(KA a, int l, int gtid, int NGT) {
    float* BB = (float*)(a->ws + WS_S5BB); f32x2* AB = (f32x2*)(a->ws + WS_S5AB);
    for (int i = gtid; i < 64 * 64; i += NGT) { const int dg = i >> 6, p = i & 63, ig = l * 64 + dg;
        const float are = a->in[10][ig * 64 + p], aim = a->in[11][ig * 64 + p];
        const float step = expf(a->in[12][ig]);
        const float mag = expf(are * step); float sn, cs; sincosf(aim * step, &sn, &cs);
        const float abr = mag * cs, abi = mag * sn, den = are * are + aim * aim, nr = abr - 1.0f;
        const float fre = (nr * are + abi * aim) / den, fim = (abi * are - nr * aim) / den;
        AB[i] = (f32x2){abr, abi};
        const float* br = a->in[13] + ((size_t)ig * 64 + p) * 16; const float* bi = a->in[14] + ((size_t)ig * 64 + p) * 16;
        float* o = BB + ((size_t)dg * 128 + 2 * p) * 16;
#pragma unroll
        for (int h = 0; h < 16; ++h) { o[h] = fre * br[h] - fim * bi[h]; o[16 + h] = fre * bi[h] + fim * br[h]; } }
}
struct S5F { f32x2 a, an; bf16x4 bhi[8], blo[8]; };
DEV void s5_load(KA a, int dg, int lane, S5F& F) {
    const float* BB = (const float*)(a->ws + WS_S5BB) + (size_t)dg * 128 * 16; const f32x2* AB = (const f32x2*)(a->ws + WS_S5AB) + dg * 64;
    F.a = AB[lane]; F.an = (f32x2){-F.a.y, F.a.x};
    const int fr = lane & 15, g4 = lane >> 4;
#pragma unroll
    for (int nt = 0; nt < 8; ++nt) { const f32x4 w = *(const f32x4*)(BB + (16 * nt + fr) * 16 + 4 * g4);
        u32x2 hi; hi.x = cvtpk(w[0], w[1]); hi.y = cvtpk(w[2], w[3]);
        u32x2 lo; lo.x = cvtpk(w[0] - bflo(hi.x), w[1] - bfhi(hi.x)); lo.y = cvtpk(w[2] - bflo(hi.y), w[3] - bfhi(hi.y));
        F.bhi[nt] = __builtin_bit_cast(bf16x4, hi); F.blo[nt] = __builtin_bit_cast(bf16x4, lo); }
}
DEV bf16x4 s5_ufrag(const bf16* PA, int dir, int g, int s0, int lane) {
    return *(const bf16x4*)(PA + (size_t)s5_row(dir, s0 + (lane & 15)) * NPA + 768 + 16 * g + 4 * (lane >> 4));
}
DEV void s5_drive(const S5F& F, bf16x4 uf, LAS float* Dr, int lane) {
    const int fr = lane & 15, g4 = lane >> 4;
#pragma unroll
    for (int nt = 0; nt < 8; ++nt) { f32x4 acc = {0.f, 0.f, 0.f, 0.f};
        acc = __builtin_amdgcn_mfma_f32_16x16x16bf16_1k(uf, F.bhi[nt], acc, 0, 0, 0); acc = __builtin_amdgcn_mfma_f32_16x16x16bf16_1k(uf, F.blo[nt], acc, 0, 0, 0);
#pragma unroll
        for (int i = 0; i < 4; ++i) Dr[(4 * g4 + i) * 132 + 16 * nt + fr] = acc[i]; }
    asm volatile("s_waitcnt lgkmcnt(0)" ::: "memory");
}
DEV void s5_pass1_wave(KA a, int l, int dg, int c0, int cstep, LAS unsigned char* wlds, int lane) {
    const int dir = dg >> 5, g = dg & 31;
    const bf16* PA = (const bf16*)(a->ws + WS_PA);
    S5F F; s5_load(a, dg, lane, F);
    LAS float* Dr = (LAS float*)wlds;
    f32x2* HEND = (f32x2*)(a->ws + WS_HEND);
    for (int c = c0; c < 260; c += cstep) {
        f32x2 h = {0.f, 0.f};
        bf16x4 uf = s5_ufrag(PA, dir, g, 64 * c, lane);
        for (int tile = 0; tile < 4; ++tile) {
            const bf16x4 un = s5_ufrag(PA, dir, g, 64 * c + 16 * (tile < 3 ? tile + 1 : tile), lane);
            s5_drive(F, uf, Dr, lane);
            f32x2 d[16];
#pragma unroll
            for (int tt = 0; tt < 16; ++tt) d[tt] = *(const LAS f32x2*)(Dr + tt * 132 + 2 * lane);
#pragma unroll
            for (int tt = 0; tt < 16; ++tt) { const f32x2 hx = {h.x, h.x}, hy = {h.y, h.y}; h = __builtin_elementwise_fma(F.a, hx, __builtin_elementwise_fma(F.an, hy, d[tt])); }
            asm volatile("s_waitcnt lgkmcnt(0)" ::: "memory");
            uf = un;
        }
        HEND[((size_t)dg * 260 + c) * 64 + lane] = h;
    }
}
DEV void s5_pass2_item(KA a, int l, int dg, int cstart, int nch, LAS unsigned char* wlds, int lane) {
    const int dir = dg >> 5, g = dg & 31, fr = lane & 15, g4 = lane >> 4;
    const bf16* PA = (const bf16*)(a->ws + WS_PA);
    S5F F; s5_load(a, dg, lane, F);
    float tr = F.a.x, ti = F.a.y;
#pragma unroll
    for (int i = 0; i < 6; ++i) { const float nr = tr * tr - ti * ti, ni = 2.f * tr * ti; tr = nr; ti = ni; }
    const f32x2* HEND = (const f32x2*)(a->ws + WS_HEND) + (size_t)dg * 260 * 64 + lane;
    float hr = 0.f, hi = 0.f;
    { const int nc = cstart; int c = 0;
      for (; c + 16 <= nc; c += 16) { f32x2 e[16];
#pragma unroll
          for (int j = 0; j < 16; ++j) e[j] = HEND[(size_t)(c + j) * 64];
#pragma unroll
          for (int j = 0; j < 16; ++j) { const float nr = tr * hr - ti * hi + e[j].x, ni = tr * hi + ti * hr + e[j].y; hr = nr; hi = ni; } }
      for (; c + 4 <= nc; c += 4) { f32x2 e[4];
#pragma unroll
          for (int j = 0; j < 4; ++j) e[j] = HEND[(size_t)(c + j) * 64];
#pragma unroll
          for (int j = 0; j < 4; ++j) { const float nr = tr * hr - ti * hi + e[j].x, ni = tr * hi + ti * hr + e[j].y; hr = nr; hi = ni; } }
      for (; c < nc; ++c) { const f32x2 e = HEND[(size_t)c * 64]; const float nr = tr * hr - ti * hi + e.x, ni = tr * hi + ti * hr + e.y; hr = nr; hi = ni; } }
    bf16x8 cf[4];
    { const int ig = (l * 2 + dir) * 32 + g; const float* cr = a->in[15] + ((size_t)ig * 16 + fr) * 64; const float* ci = a->in[16] + ((size_t)ig * 16 + fr) * 64;
#pragma unroll
        for (int ks = 0; ks < 4; ++ks) { const int p0 = 16 * ks + 4 * g4; u32x4 w;
            w.x = cvtpk(cr[p0], -ci[p0]); w.y = cvtpk(cr[p0 + 1], -ci[p0 + 1]); w.z = cvtpk(cr[p0 + 2], -ci[p0 + 2]); w.w = cvtpk(cr[p0 + 3], -ci[p0 + 3]);
            cf[ks] = __builtin_bit_cast(bf16x8, w); } }
    f32x2 hh = {hr, hi};
    LAS float* Dr = (LAS float*)wlds;
    LAS unsigned* Hs = (LAS unsigned*)(wlds + 8448);
    float* OUT = (float*)(a->ws + (dir == 0 ? WS_OUTF : WS_OUTB));
    const int sbase = 64 * cstart, ntile = 4 * nch;
    bf16x4 uf = s5_ufrag(PA, dir, g, sbase, lane);
    for (int tile = 0; tile < ntile; ++tile) {
        const bf16x4 un = s5_ufrag(PA, dir, g, sbase + 16 * (tile < ntile - 1 ? tile + 1 : tile), lane);
        s5_drive(F, uf, Dr, lane);
        f32x2 d[16];
#pragma unroll
        for (int tt = 0; tt < 16; ++tt) d[tt] = *(const LAS f32x2*)(Dr + tt * 132 + 2 * lane);
#pragma unroll
        for (int tt = 0; tt < 16; ++tt) { const f32x2 hx = {hh.x, hh.x}, hy = {hh.y, hh.y};
            hh = __builtin_elementwise_fma(F.a, hx, __builtin_elementwise_fma(F.an, hy, d[tt])); Hs[tt * 68 + lane] = cvtpk(hh.x, hh.y); }
        asm volatile("s_waitcnt lgkmcnt(0)" ::: "memory");
        f32x4 acc = {0.f, 0.f, 0.f, 0.f};
#pragma unroll
        for (int ks = 0; ks < 4; ++ks) { const bf16x8 af = *(const LAS bf16x8*)((const LAS unsigned char*)Hs + fr * 272 + 64 * ks + 16 * g4);
            acc = __builtin_amdgcn_mfma_f32_16x16x32_bf16(af, cf[ks], acc, 0, 0, 0); }
        asm volatile("s_waitcnt lgkmcnt(0)" ::: "memory");
        const int s0 = sbase + 16 * tile + 4 * g4;
#pragma unroll
        for (int i = 0; i < 4; ++i) OUT[(size_t)s5_row(dir, s0 + i) * MW + 16 * g + fr] = acc[i];
        uf = un;
    }
}
DEV void s5_glu_prep(KA a, int l, int nrows, int gtid, int NGT) {
    const bf16* PA = (const bf16*)(a->ws + WS_PA); const float* OF = (const float*)(a->ws + WS_OUTF); const float* OB = (const float*)(a->ws + WS_OUTB);
    bf16* G = (bf16*)(a->ws + WS_G); const float* dsk = a->in[17] + l * 512;
    for (int i = gtid; i < nrows * 64; i += NGT) { const int row = i >> 6, c8 = (i & 63) * 8; float u[8], o[8];
        unpack8(*(const u32x4*)(PA + (size_t)row * NPA + 768 + c8), u);
        const float* f = OF + (size_t)row * MW + c8; const float* b = OB + (size_t)row * MW + c8;
        const f32x4 f0 = *(const f32x4*)f, f1 = *(const f32x4*)(f + 4), b0 = *(const f32x4*)b, b1 = *(const f32x4*)(b + 4);
        const f32x4 d0 = *(const f32x4*)(dsk + c8), d1 = *(const f32x4*)(dsk + c8 + 4);
#pragma unroll
        for (int e = 0; e < 8; ++e) { const float y = u[e] * (e < 4 ? d0[e & 3] : d1[e & 3]) + (e < 4 ? f0[e & 3] : f1[e & 3]) + (e < 4 ? b0[e & 3] : b1[e & 3]);
            const float z = 0.7978845608028654f * (y + 0.044715f * y * y * y); const float th = 1.0f - 2.0f / (__expf(2.0f * z) + 1.0f);
            o[e] = 0.5f * y * (1.0f + th); }
        *(u32x4*)(G + (size_t)row * MW + c8) = pack8(o); }
}

template <int ID, class Epi> DEV void run_gemm(LAS unsigned char* lds, const bf16* A, int lda, const bf16* Bt, int ldb, int M, int N, int K, const Epi& E, int zS) {
    pg8::Gemm g{A, Bt, M, N, K, lda, ldb}; int bid_l = blockIdx.x; asm volatile("" : "+s"(bid_l)); pg8::StaticOrder S; S.init(M, N, K, (int)gridDim.x, bid_l, zS);
#ifndef NO_GEMM
    if constexpr (((GEMM_MASK) >> ID) & 1) pg8::gemm_phase<Epi, pg8::StaticOrder, true, true>(lds, g, S, E);
#endif
}

#define PHASE_VARS const KA a = kargs(); unsigned char* const ws = a->ws; int tid_l = threadIdx.x; asm volatile("" : "+v"(tid_l)); int bid_l = blockIdx.x; asm volatile("" : "+s"(bid_l)); const int tid = tid_l, bid = bid_l, lane = tid & 63, wave = __builtin_amdgcn_readfirstlane(tid >> 6); \
    const int G = gridDim.x, NGW = G * NWAVES, gw = bid * NWAVES + wave, NGT = G * NTHR, gtid = bid * NTHR + tid; (void)bid; LAS unsigned char* const wlds = lds + wave * 16384; \
    (void)ws; (void)lane; (void)NGW; (void)gw; (void)NGT; (void)gtid; (void)wlds; \
    const float* const MODV = (const float*)(ws + WS_MODV); const float* const modx = MODV + (size_t)(l * 2 + 0) * 12288; const float* const modz = MODV + (size_t)(l * 2 + 1) * 12288; (void)modx; (void)modz; \
    const int Mrest = (l == 0) ? MT : L; (void)Mrest;

__global__ void __launch_bounds__(NTHR, 2) fwd(Args a_formal_unused) {
    extern __shared__ __attribute__((aligned(16))) unsigned char lds_raw[];
    LAS unsigned char* const lds = (LAS unsigned char*)lds_raw;
    cg::grid_group grid = cg::this_grid();
    { const int t0 = threadIdx.x; if (t0 < 64) ((LAS unsigned*)(lds + LDS_CTL))[t0] = 0u;
      if (blockIdx.x == 0) { unsigned* bw = (unsigned*)(kargs()->ws + WS_BAR); for (int i = t0; i < XCD_BAR_WORDS; i += NTHR) bw[i] = 0u; }
      __syncthreads(); }
#define GBAR() do { XcdBarrier b_; b_.bar = (unsigned*)(kargs()->ws + WS_BAR); b_.x = xb_xcc_id(); b_.st = (volatile LAS unsigned*)(lds + LDS_CTL); xcd_barrier(b_); } while (0)

    { const int l = 0; PHASE_VARS
#ifndef NO_P0
      for (int rep_ = 0; rep_ < REP_P0; ++rep_) {
      convert_weights(a, 0, lds, gw, NGW, wave, lane, 0);
      modp_items(a, gw, NGW, lane); }
#endif
    }
    grid.sync();
    (void)xcd_barrier_post((unsigned*)(kargs()->ws + WS_BAR), (volatile LAS unsigned*)(lds + LDS_CTL));
    { const int l = 0; PHASE_VARS
      modv_reduce(a, gtid, NGT); }
    GBAR();

#pragma unroll 1
    for (int l = 0; l < 2; ++l) {
        { PHASE_VARS
          if (l == 1) for (int rep_ = 0; rep_ < REP_CW1; ++rep_) convert_weights(a, 1, lds, gw, NGW, wave, lane, 0);
          s5_tables(a, l, gtid, NGT);
          for (int rep_ = 0; rep_ < REP_NORM; ++rep_)
          norm_rows((l == 0) ? a->in[0] : a->out, (l == 0) ? a->in[2] : (const float*)(ws + WS_Z), a->in[6] + l * DM, modx, modz, 0, 1, (bf16*)(ws + WS_H), MT, gw, NGW, lane,
                    (l == 1) ? (const float*)(ws + WS_OUTF) : nullptr, 32, MODV + 12288 + 5 * DM, (float*)(ws + WS_Z)); }
        GBAR();
        { PHASE_VARS
          EpiIn E{ws};
          for (int rep_ = 0; rep_ < REP_G1; ++rep_)
          run_gemm<1>(lds, (const bf16*)(ws + WS_H), DM, (const bf16*)(ws + WS_WIN), DM, L, NIN, DM, E, 1); }
        GBAR();
        { PHASE_VARS
          const int nconv = L / 16 + (l == 0 ? LC / 16 : 0);
#ifndef NO_CONV
          for (int rep_ = 0; rep_ < REP_CONV * REP_MIXA; ++rep_)
          for (int it = bid; it < 1024 + 216; it += G) { const bool cz = it >= 1024; if (cz && (l != 0 || it < 1224)) continue; conv_item(a, l, cz ? 1024 + (it - 1224) : it, lds, tid); }
#endif
        }
#ifndef NO_ATTN
        { PHASE_VARS
          const int nA = 2048 + ((l == 0) ? 32 : 0);
          for (int rep_ = 0; rep_ < REP_MIXA * REP_ATTA; ++rep_)
          for (int it = gw; it < 3072 + 32; it += NGW) { const bool cx = it >= 2048; if (cx && (l != 0 || it < 3072)) continue; attnA_item(a, l, cx ? it - 3072 : it, cx, lane); } }
        { PHASE_VARS
          const int nC = 2048 + ((l == 0) ? 32 : 0);
          for (int rep_ = 0; rep_ < REP_MIXA * REP_ATTC; ++rep_)
          for (int it = gw; it < 2048; it += NGW) attnC_item(a, l, it, false, (LAS float*)wlds, lane); }
        if (l == 0) { PHASE_VARS
          for (int it = (gw + NGW - (1536 % NGW)) % NGW; it < 32; it += NGW) attnC_item(a, l, it, true, (LAS float*)wlds, lane); }
#endif
#ifndef NO_S51
        { PHASE_VARS
          for (int rep_ = 0; rep_ < REP_MIXA * REP_S51; ++rep_)
          if ((NGW & 63) == 0) s5_pass1_wave(a, l, gw & 63, gw >> 6, NGW >> 6, wlds, lane);
          else for (int it = gw; it < 64 * 260; it += NGW) s5_pass1_wave(a, l, it / 260, it % 260, 260, wlds, lane); }
#endif
        GBAR();
        { PHASE_VARS
          const int c0 = (l == 0) ? 0 : 4, rl = (l == 0) ? 10 : 8, nrg = (260 - c0) / rl;
#ifndef NO_S52
          for (int rep_ = 0; rep_ < REP_MIXB; ++rep_)
          for (int it = gw; it < 64 * nrg; it += NGW) s5_pass2_item(a, l, it / nrg, c0 + rl * (it % nrg), rl, wlds, lane);
#endif
        }
        GBAR();
        { PHASE_VARS
          for (int rep_ = 0; rep_ < REP_MIXC; ++rep_) s5_glu_prep(a, l, Mrest, gtid, NGT); }
        GBAR();
        { PHASE_VARS
          EpiGlu E{ws, a->in[19] + l * 512};
          run_gemm<2>(lds, (const bf16*)(ws + WS_G), MW, (const bf16*)(ws + WS_WGLU), MW, L, MW, MW, E, (l == 0) ? 1 : 0); }
        GBAR();
        for (int rep_ = 0; rep_ < REP_G3; ++rep_)
        { PHASE_VARS
          EpiMerge E{ws};
          run_gemm<3>(lds, (const bf16*)(ws + WS_Y), DM, (const bf16*)(ws + WS_WBR), DM, L, DM, DM, E, (l == 0) ? 1 : 0); }
        GBAR();
        { PHASE_VARS
          for (int rep_ = 0; rep_ < REP_G4; ++rep_) {
          EpiRes E{(l == 0) ? a->in[0] : a->out, (rep_ + 1 < REP_G4) ? (float*)(ws + WS_PA) : a->out, (float*)(ws + WS_OUTF), modx + 2 * DM};
          run_gemm<4>(lds, (const bf16*)(ws + WS_H), DM, (const bf16*)(ws + WS_WOUT), DM, L, DM, DM, E, (l == 0) ? 16 : 0); } }
        GBAR();
        { PHASE_VARS
          for (int rep_ = 0; rep_ < REP_NORM; ++rep_)
          norm_rows(a->out, (l == 0) ? a->in[2] : (const float*)(ws + WS_Z), a->in[7] + l * DM, modx, modz, 3, 4, (bf16*)(ws + WS_H), Mrest, gw, NGW, lane,
                    (l == 0) ? (const float*)(ws + WS_OUTF) : nullptr, 16, modz + 2 * DM, (float*)(ws + WS_Z)); }
        GBAR();
        { PHASE_VARS
          EpiRelu2 E{(bf16*)(ws + WS_PG), (float*)(ws + WS_OUTF)};
          for (int rep_ = 0; rep_ < REP_G5; ++rep_)
          run_gemm<5>(lds, (const bf16*)(ws + WS_H), DM, (const bf16*)(ws + WS_W1), DM, L, DFF, DM, E, (l == 0) ? 8 : 0); }
        GBAR();
        if (l == 0) { { PHASE_VARS
          zfin_relu2((const float*)(ws + WS_OUTF), 8, (bf16*)(ws + WS_PG), gtid, NGT); }
          GBAR(); }
        { PHASE_VARS
          for (int rep_ = 0; rep_ < REP_G6; ++rep_) {
          EpiRes E{a->out, (rep_ + 1 < REP_G6) ? (float*)(ws + WS_PA) : a->out, (float*)(ws + WS_OUTF), modx + 5 * DM};
          run_gemm<6>(lds, (const bf16*)(ws + WS_PG), DFF, (const bf16*)(ws + WS_W2), DFF, L, DM, DFF, E, (l == 0) ? 32 : 0); } }
        GBAR();
    }
    for (int rep_ = 1; rep_ < REP_SYNC; ++rep_) GBAR();
    { const int l = 0; PHASE_VARS
      final_rows(a->out, a->in[29], gw, NGW, lane); }
}

extern "C" void kernel_launch(void* const* d_in, const int* in_sizes, int n_in, void* d_out, int out_size, void* d_ws, size_t ws_size, hipStream_t stream) {
    static int grid = 0;
    if (grid == 0) {
        if (n_in != 30 || out_size != L * DM || ws_size < WS_END) { fprintf(stderr, "kernel_launch: unexpected shapes: n_in %d out %d ws %zu (need %zu)\n", n_in, out_size, ws_size, (size_t)WS_END); grid = -1; return; }
        int dev = 0, cus = 0, per_cu = 0;
        (void)hipGetDevice(&dev);
        (void)hipDeviceGetAttribute(&cus, hipDeviceAttributeMultiprocessorCount, dev);
        (void)hipFuncSetAttribute((const void*)fwd, hipFuncAttributeMaxDynamicSharedMemorySize, LDS_BYTES);
        (void)hipOccupancyMaxActiveBlocksPerMultiprocessor(&per_cu, (const void*)fwd, NTHR, LDS_BYTES);
        if (per_cu < 1) per_cu = 1;
        grid = cus * per_cu;
        fprintf(stderr, "grid %d (cus %d per_cu %d) ws_size %zu\n", grid, cus, per_cu, ws_size);
    }
    if (grid < 0) return;
    Args a{};
    for (int i = 0; i < 30; ++i) a.in[i] = (const float*)d_in[i];
    a.out = (float*)d_out; a.ws = (unsigned char*)d_ws;
    void* args[] = {&a};
    hipError_t e = hipLaunchCooperativeKernel((void*)fwd, dim3(grid), dim3(NTHR), args, LDS_BYTES, stream);
    if (e != hipSuccess) fprintf(stderr, "cooperative launch failed: %s (grid %d)\n", hipGetErrorString(e), grid);
}
```

```cpp
#include <hip/hip_runtime.h>
#include <hip/hip_cooperative_groups.h>
#include <cstdio>
#include <cstdint>
namespace pg8 {
#define PG8_LAS __attribute__((address_space(3)))
typedef unsigned short bf16_t;
typedef short bf16x8 __attribute__((ext_vector_type(8)));
typedef float f32x4 __attribute__((ext_vector_type(4)));
typedef unsigned u32x4 __attribute__((ext_vector_type(4)));
constexpr int BM = 256, BK = 64, HALF = 128, HTB = HALF * BK * 2  , STAGE_BYTES = 8 * HTB, NXCD = 8, WGM = 8;

__host__ __device__ __forceinline__ int lds_byte(int r, int c) { const int st = (r >> 4) * 2 + (c >> 5), rr = r & 15, cc = c & 31, ob = rr * 64 + cc * 2; return st * 1024 + (ob ^ (((ob >> 9) & 1) << 5)); }
__host__ __device__ __forceinline__ void stage_rc(int b, int& R, int& C) { const int st = b / 1024, sb = b % 1024, swz = sb ^ (((sb >> 9) & 1) << 5); R = (st >> 1) * 16 + swz / 64; C = (st & 1) * 32 + (swz % 64) / 2; }
__host__ __device__ __forceinline__ int perm32(int rho) { const int n = rho >> 4, i = rho & 15; return 8 * (i >> 2) + 4 * n + (i & 3); }

struct Unit { int pm, pn, kn; __host__ __device__ int kofs() const { return kn & 0xffff; } __host__ __device__ int nt() const { return kn >> 16; } };
struct Gemm { const bf16_t* A; const bf16_t* Bt; int M, N, K, lda, ldb; };

struct StaticOrder {
    int nM, nN, nwg, G, c, ntk, zS, ntot;
    __host__ __device__ void init(int M, int N, int K, int G_, int c_, int zS_) { nM = M / BM; nN = N / BM; nwg = nM * nN; G = G_; c = c_; ntk = K / BK; zS = zS_; ntot = nwg + nN * zS_; }
    __host__ __device__ bool next(int i, Unit& u) const {
        const long L = (long)i * G + c; if (L >= ntot) return false;
        if (L >= nwg) { const int j = (int)L - nwg; u.pm = nM; u.pn = j % nN; { const int nt_ = ntk / zS; u.kn = (nt_ << 16) | ((j / nN) * nt_ * BK); } return true; }
        int wgid = (int)L; { const int q = nwg / NXCD, r = nwg % NXCD, xcd = wgid % NXCD, off = wgid / NXCD; wgid = (xcd < r ? xcd * (q + 1) : r * (q + 1) + (xcd - r) * q) + off; }
        const int nig = WGM * nN, gid = wgid / nig, fm = gid * WGM, gsz = (nM - fm) < WGM ? (nM - fm) : WGM;
        u.pm = fm + ((wgid % nig) % gsz); u.pn = (wgid % nig) / gsz; u.kn = ntk << 16; return true;
    }
    __device__ __forceinline__ void a_ready(const Unit&) const {}
    __device__ __forceinline__ void done(const Unit&) const {}
};

__device__ __forceinline__ unsigned cvt_pk_bf16(float lo, float hi) { unsigned r; asm volatile("v_cvt_pk_bf16_f32 %0, %1, %2" : "=v"(r) : "v"(lo), "v"(hi)); return r; }
typedef float f32x2 __attribute__((ext_vector_type(2)));
template <class Epi, class Sched, bool ALIGN_EPI = false, bool SP2 = false>
__device__ __forceinline__ void gemm_phase(PG8_LAS unsigned char* lds, const Gemm g, const Sched& S, const Epi& E) {
    int tid_l = threadIdx.x; asm volatile("" : "+v"(tid_l));
    const int tid = tid_l, wid = __builtin_amdgcn_readfirstlane(tid >> 6), lane = tid & 63, wr = wid >> 2, wc = wid & 3, fr = lane & 15, fq = lane >> 4;
    unsigned voffA[2], voffB[2];
#pragma unroll
    for (int i = 0; i < 2; ++i) { int R, C; stage_rc(tid * 16 + i * 8192, R, C); const int Rb = Epi::PERM ? ((R & ~31) + perm32(R & 31)) : R;
        voffA[i] = (unsigned)(R * g.lda + C) * 2u; voffB[i] = (unsigned)(Rb * g.ldb + C) * 2u; }
    const size_t kstep = (size_t)(BK * 2);
    const unsigned hstepA = (unsigned)(HALF * g.lda * 2), hstepB = (unsigned)(HALF * g.ldb * 2);
    const unsigned ldsw = (unsigned)wid * 1024u;
    const int aoff = lds_byte(wr * 64 + fr, fq * 8), boff = lds_byte(wc * 32 + fr, fq * 8);
#define PG8_SA(b, h) (((b) * 2 + (h)) * HTB)
#define PG8_SB(b, h) ((4 + (b) * 2 + (h)) * HTB)
#define PG8_STAGE(bufoff, gbase, voff) do { _Pragma("unroll") for (int _i = 0; _i < 2; ++_i) \
        __builtin_amdgcn_global_load_lds((const unsigned*)((const char*)(gbase) + (voff)[_i]), (PG8_LAS unsigned*)(lds + (bufoff) + ldsw + _i * 8192), 16, 0, 0); } while (0)
#define PG8_LDA(dst, b, h) do { _Pragma("unroll") for (int m = 0; m < 4; ++m) _Pragma("unroll") for (int k = 0; k < 2; ++k) dst[m][k] = *(const PG8_LAS bf16x8*)(lds + PG8_SA(b, h) + aoff + m * 2048 + k * 1024); } while (0)
#define PG8_LDB(dst, b, h) do { _Pragma("unroll") for (int n = 0; n < 2; ++n) _Pragma("unroll") for (int k = 0; k < 2; ++k) dst[n][k] = *(const PG8_LAS bf16x8*)(lds + PG8_SB(b, h) + boff + n * 2048 + k * 1024); } while (0)
#define PG8_MMA(ai, bj, At, Bt) do { __builtin_amdgcn_s_setprio(1); _Pragma("unroll") for (int m = 0; m < 4; ++m) _Pragma("unroll") for (int n = 0; n < 2; ++n) _Pragma("unroll") for (int k = 0; k < 2; ++k) \
        acc[ai][bj][m][n] = __builtin_amdgcn_mfma_f32_16x16x32_bf16(Bt[n][k], At[m][k], acc[ai][bj][m][n], 0, 0, 0); __builtin_amdgcn_s_setprio(0); } while (0)
#define PG8_WAIT_V(n) asm volatile("s_waitcnt vmcnt(" #n ")" ::: "memory")
#define PG8_WAIT_L(n) asm volatile("s_waitcnt lgkmcnt(" #n ")" ::: "memory")
#define PG8_BAR __builtin_amdgcn_s_barrier()
#define PG8_SCHED __builtin_amdgcn_sched_barrier(0)
    Unit cur, nxt; int ui = 0;
    if (!S.next(0, cur)) return;
    f32x4 acc[2][2][4][2];
#pragma unroll
    for (int a = 0; a < 2; ++a)
#pragma unroll
        for (int b = 0; b < 2; ++b)
#pragma unroll
            for (int m = 0; m < 4; ++m)
#pragma unroll
                for (int n = 0; n < 2; ++n) acc[a][b][m][n] = (f32x4){0.f, 0.f, 0.f, 0.f};
    bf16x8 At[4][2], B0[2][2], B1[2][2];
    const char* cA = (const char*)g.A + (size_t)cur.pm * (2 * hstepA) + (size_t)cur.kofs() * 2; const char* cB = (const char*)g.Bt + (size_t)cur.pn * (2 * hstepB) + (size_t)cur.kofs() * 2;
    S.a_ready(cur);
    if constexpr (SP2) {
        PG8_STAGE(PG8_SB(0, 0), cB, voffB); PG8_STAGE(PG8_SB(0, 1), cB + hstepB, voffB); PG8_STAGE(PG8_SA(0, 0), cA, voffA); PG8_STAGE(PG8_SA(0, 1), cA + hstepA, voffA);
        if (wr == 1) PG8_BAR;
        PG8_WAIT_V(2); PG8_BAR;
        PG8_STAGE(PG8_SB(1, 0), cB + kstep, voffB); PG8_STAGE(PG8_SA(1, 0), cA + kstep, voffA); PG8_STAGE(PG8_SB(1, 1), cB + hstepB + kstep, voffB);
        PG8_WAIT_V(6); PG8_BAR;
    } else {
        PG8_STAGE(PG8_SB(0, 0), cB, voffB); PG8_STAGE(PG8_SA(0, 0), cA, voffA); PG8_STAGE(PG8_SB(0, 1), cB + hstepB, voffB); PG8_STAGE(PG8_SA(0, 1), cA + hstepA, voffA);
        if (wr == 1) PG8_BAR;
        PG8_WAIT_V(4); PG8_BAR;
        PG8_STAGE(PG8_SB(1, 0), cB + kstep, voffB); PG8_STAGE(PG8_SA(1, 0), cA + kstep, voffA); PG8_STAGE(PG8_SB(1, 1), cB + hstepB + kstep, voffB);
        PG8_WAIT_V(6); PG8_BAR;
    }
    for (;;) {
        const bool has_next = S.next(ui + 1, nxt);
        const char* nA = has_next ? (const char*)g.A + (size_t)nxt.pm * (2 * hstepA) + (size_t)nxt.kofs() * 2 : cA; const char* nB = has_next ? (const char*)g.Bt + (size_t)nxt.pn * (2 * hstepB) + (size_t)nxt.kofs() * 2 : cB;
        const int nt = cur.nt();
        for (int t = 0; t < nt; t += 2) {
            const bool last = (t == nt - 2);
            const char* a1 = cA + (size_t)(t + 1) * kstep;
            const char* a2 = last ? nA : cA + (size_t)(t + 2) * kstep; const char* b2 = last ? nB : cB + (size_t)(t + 2) * kstep;
            const char* a3 = a2 + kstep; const char* b3 = b2 + kstep;
            if (last && has_next) S.a_ready(nxt);
            if constexpr (SP2) {
            PG8_LDB(B0, 0, 0); PG8_LDB(B1, 0, 1); PG8_SCHED; PG8_LDA(At, 0, 0); PG8_STAGE(PG8_SA(1, 1), a1 + hstepA, voffA);
            PG8_WAIT_V(8); PG8_WAIT_L(0); PG8_BAR; PG8_MMA(0, 0, At, B0); PG8_MMA(0, 1, At, B1); PG8_BAR; PG8_SCHED;
            PG8_LDA(At, 0, 1); PG8_STAGE(PG8_SB(0, 0), b2, voffB); PG8_STAGE(PG8_SB(0, 1), b2 + hstepB, voffB); PG8_STAGE(PG8_SA(0, 0), a2, voffA);
            PG8_WAIT_V(8); PG8_WAIT_L(0); PG8_BAR; PG8_MMA(1, 0, At, B0); PG8_MMA(1, 1, At, B1); PG8_BAR; PG8_SCHED;
            PG8_LDB(B0, 1, 0); PG8_LDB(B1, 1, 1); PG8_SCHED; PG8_LDA(At, 1, 0); PG8_STAGE(PG8_SA(0, 1), a2 + hstepA, voffA);
            PG8_WAIT_V(8); PG8_WAIT_L(0); PG8_BAR; PG8_MMA(0, 0, At, B0); PG8_MMA(0, 1, At, B1); PG8_BAR; PG8_SCHED;
            PG8_LDA(At, 1, 1); PG8_STAGE(PG8_SB(1, 0), b3, voffB); PG8_STAGE(PG8_SB(1, 1), b3 + hstepB, voffB); PG8_STAGE(PG8_SA(1, 0), a3, voffA);
            PG8_WAIT_V(8); PG8_WAIT_L(0); PG8_BAR; PG8_MMA(1, 0, At, B0); PG8_MMA(1, 1, At, B1); PG8_BAR; PG8_SCHED;
            } else {
            PG8_LDB(B0, 0, 0); PG8_SCHED; PG8_LDA(At, 0, 0); PG8_STAGE(PG8_SA(1, 1), a1 + hstepA, voffA);
            PG8_WAIT_L(8); PG8_BAR; PG8_WAIT_L(0); PG8_MMA(0, 0, At, B0); PG8_BAR; PG8_SCHED;
            PG8_LDB(B1, 0, 1); PG8_STAGE(PG8_SB(0, 0), b2, voffB);
            PG8_BAR; PG8_WAIT_L(0); PG8_MMA(0, 1, At, B1); PG8_BAR;
            PG8_LDA(At, 0, 1); PG8_STAGE(PG8_SA(0, 0), a2, voffA);
            PG8_BAR; PG8_WAIT_L(0); PG8_MMA(1, 0, At, B0); PG8_BAR; PG8_SCHED;
            PG8_STAGE(PG8_SB(0, 1), b2 + hstepB, voffB);
            PG8_WAIT_V(6); PG8_BAR; PG8_MMA(1, 1, At, B1); PG8_BAR;
            PG8_LDB(B0, 1, 0); PG8_SCHED; PG8_LDA(At, 1, 0); PG8_STAGE(PG8_SA(0, 1), a2 + hstepA, voffA);
            PG8_WAIT_L(8); PG8_BAR; PG8_WAIT_L(0); PG8_MMA(0, 0, At, B0); PG8_BAR; PG8_SCHED;
            PG8_LDB(B1, 1, 1); PG8_STAGE(PG8_SB(1, 0), b3, voffB);
            PG8_BAR; PG8_WAIT_L(0); PG8_MMA(0, 1, At, B1); PG8_BAR;
            PG8_LDA(At, 1, 1); PG8_STAGE(PG8_SA(1, 0), a3, voffA);
            PG8_BAR; PG8_WAIT_L(0); PG8_MMA(1, 0, At, B0); PG8_BAR; PG8_SCHED;
            PG8_STAGE(PG8_SB(1, 1), b3 + hstepB, voffB);
            PG8_WAIT_V(6); PG8_BAR; PG8_MMA(1, 1, At, B1); PG8_BAR;
            }
            if constexpr (Epi::HAS_MID) { if (((t + 2) & 7) == 0 && t + 2 < nt) E.mid(acc, cur, (t + 2) >> 3, wr, wc, fr, fq); }
        }
        if constexpr (ALIGN_EPI) { if (wr == 0) PG8_BAR; }
        if constexpr (!Epi::AFTER_DRAIN) { E(acc, cur, wr, wc, fr, fq); S.done(cur); }
        if (!has_next) break;
#pragma unroll
        for (int a = 0; a < 2; ++a)
#pragma unroll
            for (int b = 0; b < 2; ++b)
#pragma unroll
                for (int m = 0; m < 4; ++m)
#pragma unroll
                    for (int n = 0; n < 2; ++n) acc[a][b][m][n] = (f32x4){0.f, 0.f, 0.f, 0.f};
        cur = nxt; cA = nA; cB = nB; ++ui;
        if constexpr (ALIGN_EPI) { if (wr == 1) PG8_BAR; }
    }
    PG8_WAIT_V(0);
    if constexpr (!ALIGN_EPI) { if (wr == 0) PG8_BAR; }
    PG8_BAR;
    if constexpr (Epi::AFTER_DRAIN) { E.fused(acc, cur, wr, wc, fr, fq, lds, wid, lane); S.done(cur); }
#undef PG8_SA
#undef PG8_SB
#undef PG8_STAGE
#undef PG8_LDA
#undef PG8_LDB
#undef PG8_MMA
#undef PG8_WAIT_V
#undef PG8_WAIT_L
#undef PG8_BAR
#undef PG8_SCHED
}
}

namespace cg = cooperative_groups;
#ifndef GEMM_MASK
#define GEMM_MASK 0xff
#endif
#ifndef REP_P0
#define REP_P0 1
#endif
#ifndef REP_NORM
#define REP_NORM 1
#endif
#ifndef REP_MIXA
#define REP_MIXA 1
#endif
#ifndef REP_MIXB
#define REP_MIXB 1
#endif
#ifndef REP_MIXC
#define REP_MIXC 1
#endif
#ifndef REP_G1
#define REP_G1 1
#endif
#ifndef REP_G3
#define REP_G3 1
#endif
#ifndef REP_G5
#define REP_G5 1
#endif
#ifndef REP_SYNC
#define REP_SYNC 1
#endif
#ifndef REP_G6
#define REP_G6 1
#endif
#ifndef REP_CW1
#define REP_CW1 1
#endif
#ifndef REP_G4
#define REP_G4 1
#endif
#ifndef REP_CONV
#define REP_CONV 1
#endif
#ifndef REP_ATTA
#define REP_ATTA 1
#endif
#ifndef REP_ATTC
#define REP_ATTC 1
#endif
#ifndef REP_S51
#define REP_S51 1
#endif
#define DEV __device__ __forceinline__
#define LAS __attribute__((address_space(3)))
typedef unsigned short bf16;
typedef short bf16x8 __attribute__((ext_vector_type(8)));
typedef float f32x4 __attribute__((ext_vector_type(4)));
typedef float f32x2 __attribute__((ext_vector_type(2)));
typedef unsigned u32x4 __attribute__((ext_vector_type(4)));
typedef unsigned u32x2 __attribute__((ext_vector_type(2)));
using pg8::Unit;

constexpr int L = 16384, LC = 256, MT = L + LC, DM = 2048, NIN = 12032, NPA = 3840, NPG = 8192, DFF = 8192, MW = 512;
constexpr int NWAVES = 8, NTHR = 512;
constexpr int LDS_BYTES = 147456;
constexpr size_t MiB = 1u << 20;
constexpr size_t WS_MODV = 0, WS_ROPE = 256 * 1024, WS_BAR = 512 * 1024, WS_MODP = 1 * MiB;
constexpr int LDS_CTL = 131072 + 1024;
constexpr size_t WS_WIN = 8 * MiB, WS_WGLU = 55 * MiB, WS_WBR = 56 * MiB, WS_WOUT = 64 * MiB, WS_W1 = 72 * MiB, WS_W2 = 104 * MiB;
constexpr size_t WS_Z = 136 * MiB, WS_H = 138 * MiB, WS_PA = 203 * MiB, WS_PG = 333 * MiB, WS_Y = 593 * MiB;
constexpr size_t WS_OUTF = 658 * MiB, WS_OUTB = WS_OUTF + (size_t)MT * MW * 4, WS_G = 723 * MiB, WS_HEND = 740 * MiB, WS_VTA = 749 * MiB, WS_VTC = 754 * MiB, WS_KA = 771 * MiB, WS_KC = 776 * MiB, WS_END = 793 * MiB;
static_assert(WS_OUTB + (size_t)MT * MW * 4 <= WS_G && WS_G + (size_t)MT * MW * 2 <= WS_HEND && WS_VTC + (size_t)512 * MT * 2 <= WS_END, "ws map");
static_assert(WS_PA + (size_t)MT * DM * 4 <= WS_PG && WS_PG + (size_t)MT * NPG * 2 <= WS_Y && WS_Y + (size_t)MT * DM * 2 <= WS_OUTF, "ws map 2");

typedef __bf16 bf16x2_t __attribute__((ext_vector_type(2)));
DEV unsigned cvtpk(float lo, float hi) { f32x2 v = {lo, hi}; bf16x2_t b = __builtin_convertvector(v, bf16x2_t); return __builtin_bit_cast(unsigned, b); }
DEV float bflo(unsigned w) { return __uint_as_float(w << 16); }
DEV float bfhi(unsigned w) { return __uint_as_float(w & 0xffff0000u); }
DEV float bf2f(bf16 b) { return __uint_as_float((unsigned)b << 16); }
DEV bf16 f2bf1(float f) { return (bf16)(cvtpk(f, 0.f) & 0xffffu); }
DEV float sigmoidf_(float x) { return __builtin_amdgcn_rcpf(1.0f + __expf(-x)); }
DEV float wave_sum(float v) {
#pragma unroll
    for (int o = 1; o < 64; o <<= 1) v += __shfl_xor(v, o);
    return v;
}
DEV void unpack8(u32x4 w, float (&v)[8]) { v[0] = bflo(w.x); v[1] = bfhi(w.x); v[2] = bflo(w.y); v[3] = bfhi(w.y); v[4] = bflo(w.z); v[5] = bfhi(w.z); v[6] = bflo(w.w); v[7] = bfhi(w.w); }
DEV u32x4 pack8(const float (&v)[8]) { u32x4 w; w.x = cvtpk(v[0], v[1]); w.y = cvtpk(v[2], v[3]); w.z = cvtpk(v[4], v[5]); w.w = cvtpk(v[6], v[7]); return w; }

DEV void zp_store(const f32x4 (&acc)[2][2][4][2], const Unit& u, int wr, int wc, int fr, int fq, float* zp, int ncols) {
    const int row0 = wr * 64 + fr, col0 = u.pn * 256 + wc * 32 + 8 * fq, ks = u.kofs() / (u.nt() * 64);
#pragma unroll
    for (int ai = 0; ai < 2; ++ai)
#pragma unroll
        for (int m = 0; m < 4; ++m) { float* rp = zp + ((size_t)ks * 256 + row0 + ai * 128 + m * 16) * ncols + col0;
#pragma unroll
            for (int bj = 0; bj < 2; ++bj) { *(f32x4*)(rp + bj * 128) = acc[ai][bj][m][0]; *(f32x4*)(rp + bj * 128 + 4) = acc[ai][bj][m][1]; } }
}
struct EpiIn {
    static constexpr bool PERM = true, AFTER_DRAIN = false, HAS_MID = false;
    unsigned char* ws;
    DEV void operator()(const f32x4 (&acc)[2][2][4][2], const Unit& u, int wr, int wc, int fr, int fq) const {
        bf16* const PA = (bf16*)(ws + WS_PA); bf16* const PG = (bf16*)(ws + WS_PG); bf16* const VTA = (bf16*)(ws + WS_VTA); bf16* const VTC = (bf16*)(ws + WS_VTC); bf16* const KA = (bf16*)(ws + WS_KA); bf16* const KC = (bf16*)(ws + WS_KC); const f32x2* const rope = (const f32x2*)(ws + WS_ROPE);
        const int row0 = u.pm * 256 + wr * 64 + fr, ct = wc * 32 + 8 * fq;
        if (u.pn >= 15) {
            const int colb = (u.pn - 15) * 256 + ct;
#pragma unroll
            for (int ai = 0; ai < 2; ++ai)
#pragma unroll
                for (int m = 0; m < 4; ++m) { bf16* rowp = PG + (size_t)(row0 + ai * 128 + m * 16) * NPG + colb;
#pragma unroll
                    for (int bj = 0; bj < 2; ++bj) { float v[8];
#pragma unroll
                        for (int e = 0; e < 4; ++e) { v[e] = sigmoidf_(acc[ai][bj][m][0][e]); v[4 + e] = sigmoidf_(acc[ai][bj][m][1][e]); }
                        *(u32x4*)(rowp + bj * 128) = pack8(v); } }
        } else {
            const bool ropeu = (u.pn <= 2) && (u.pm < 64);
            const int colb = u.pn * 256 + ct;
            const float sgn = (fq >> 1) ? 1.f : -1.f;
#pragma unroll
            for (int ai = 0; ai < 2; ++ai)
#pragma unroll
                for (int m = 0; m < 4; ++m) { const int row = row0 + ai * 128 + m * 16; bf16* rowp = PA + (size_t)row * NPA + colb;
#pragma unroll
                    for (int bj = 0; bj < 2; ++bj) { float v[8];
#pragma unroll
                        for (int e = 0; e < 4; ++e) { v[e] = acc[ai][bj][m][0][e]; v[4 + e] = acc[ai][bj][m][1][e]; }
                        if (ropeu && !(u.pn == 2 && bj == 1)) {
                            const int pos = (wc & 1) ? (row & 63) : (row >> 6);
                            const f32x2* tab = rope + pos * 16 + 8 * (fq & 1);
#pragma unroll
                            for (int e = 0; e < 8; ++e) { const float pv = __shfl_xor(v[e], 32); const f32x2 cs = tab[e]; v[e] = v[e] * cs.x + sgn * pv * cs.y; }
                        }
                        const u32x4 pw = pack8(v);
                        *(u32x4*)(rowp + bj * 128) = pw;
                        if (u.pn == 2) { const int hk = ct >> 6, d0 = ct & 63;
                            if (bj == 0) *(u32x4*)(KA + ((size_t)hk * MT + row) * 64 + d0) = pw;
                            else { bf16* vp = VTA + (((size_t)hk * (MT / 16) + (row >> 4)) * 64 + d0) * 16 + (row & 15);
#pragma unroll
                                for (int e = 0; e < 8; ++e) vp[e * 16] = f2bf1(v[e]); } }
                        if (u.pn == 7 || u.pn == 8) { const int cv = (u.pn - 7) * 256 + bj * 128 + ct, hh = cv >> 6, d0 = cv & 63;
                            *(u32x4*)(KC + ((size_t)hh * MT + row) * 64 + d0) = pw; }
                        if (u.pn == 9 || u.pn == 10) { const int cv = (u.pn - 9) * 256 + bj * 128 + ct, hh = cv >> 6, d0 = cv & 63;
                            bf16* vp = VTC + (((size_t)hh * (MT / 16) + (row >> 4)) * 64 + d0) * 16 + (row & 15);
#pragma unroll
                            for (int e = 0; e < 8; ++e) vp[e * 16] = f2bf1(v[e]); }
                    } }
        }
    }
};
struct EpiGlu {
    static constexpr bool PERM = true, AFTER_DRAIN = false, HAS_MID = false;
    unsigned char* ws; const float* bias;
    DEV void operator()(const f32x4 (&acc)[2][2][4][2], const Unit& u, int wr, int wc, int fr, int fq) const {
        const bf16* const G = (const bf16*)(ws + WS_G); bf16* const Y = (bf16*)(ws + WS_Y);
        const int row0 = u.pm * 256 + wr * 64 + fr, col0 = u.pn * 256 + wc * 32 + 8 * fq;
        f32x4 bb[2][2];
#pragma unroll
        for (int bj = 0; bj < 2; ++bj) { bb[bj][0] = *(const f32x4*)(bias + col0 + bj * 128); bb[bj][1] = *(const f32x4*)(bias + col0 + bj * 128 + 4); }
#pragma unroll
        for (int ai = 0; ai < 2; ++ai) { u32x4 gw_[4][2];
#pragma unroll
            for (int m = 0; m < 4; ++m)
#pragma unroll
                for (int bj = 0; bj < 2; ++bj) gw_[m][bj] = *(const u32x4*)(G + (size_t)(row0 + ai * 128 + m * 16) * MW + col0 + bj * 128);
            asm volatile("" ::: "memory");
#pragma unroll
            for (int m = 0; m < 4; ++m) { const int row = row0 + ai * 128 + m * 16;
#pragma unroll
                for (int bj = 0; bj < 2; ++bj) { float g[8], v[8]; unpack8(gw_[m][bj], g);
#pragma unroll
                    for (int e = 0; e < 4; ++e) { v[e] = g[e] * sigmoidf_(acc[ai][bj][m][0][e] + bb[bj][0][e]); v[4 + e] = g[4 + e] * sigmoidf_(acc[ai][bj][m][1][e] + bb[bj][1][e]); }
                    *(u32x4*)(Y + (size_t)row * DM + 512 + col0 + bj * 128) = pack8(v); } } }
    }
};
struct EpiMerge {
    static constexpr bool PERM = true, AFTER_DRAIN = false, HAS_MID = true;
    unsigned char* ws;
    DEV void mid(f32x4 (&acc)[2][2][4][2], const Unit& u, int sec  , int wr, int wc, int fr, int fq) const {
        const bf16* const PG = (const bf16*)(ws + WS_PG);
        const int row0 = u.pm * 256 + wr * 64 + fr, col0 = u.pn * 256 + wc * 32 + 8 * fq;
        u32x4 w0[4][2], w1[4][2];
#pragma unroll
        for (int m = 0; m < 4; ++m) { const bf16* gp = PG + (size_t)(row0 + m * 16) * NPG + (sec - 1) * DM + col0;
#pragma unroll
            for (int bj = 0; bj < 2; ++bj) { w0[m][bj] = *(const u32x4*)(gp + bj * 128); w1[m][bj] = *(const u32x4*)(gp + DM + bj * 128); } }
#pragma unroll
        for (int ai = 0; ai < 2; ++ai)
#pragma unroll
            for (int m = 0; m < 4; ++m)
#pragma unroll
                for (int bj = 0; bj < 2; ++bj) { float g0[8], g1[8]; unpack8(w0[m][bj], g0); unpack8(w1[m][bj], g1);
                    if (ai == 0) { const bf16* gp = PG + (size_t)(row0 + 128 + m * 16) * NPG + (sec - 1) * DM + col0 + bj * 128; w0[m][bj] = *(const u32x4*)gp; w1[m][bj] = *(const u32x4*)(gp + DM); }
#pragma unroll
                    for (int e = 0; e < 4; ++e) { acc[ai][bj][m][0][e] *= g0[e] * __builtin_amdgcn_rcpf(fmaxf(g1[e], 1e-30f)); acc[ai][bj][m][1][e] *= g0[4 + e] * __builtin_amdgcn_rcpf(fmaxf(g1[4 + e], 1e-30f)); } }
    }
    DEV void operator()(const f32x4 (&acc)[2][2][4][2], const Unit& u, int wr, int wc, int fr, int fq) const {
        const bf16* const PG = (const bf16*)(ws + WS_PG); bf16* const Mb = (bf16*)(ws + WS_H);
        const int row0 = u.pm * 256 + wr * 64 + fr, col0 = u.pn * 256 + wc * 32 + 8 * fq;
#pragma unroll
        for (int ai = 0; ai < 2; ++ai) { u32x4 w3[4][2];
#pragma unroll
            for (int m = 0; m < 4; ++m)
#pragma unroll
                for (int bj = 0; bj < 2; ++bj) w3[m][bj] = *(const u32x4*)(PG + (size_t)(row0 + ai * 128 + m * 16) * NPG + 3 * DM + col0 + bj * 128);
            asm volatile("" ::: "memory");
#pragma unroll
            for (int m = 0; m < 4; ++m) { const int row = row0 + ai * 128 + m * 16;
#pragma unroll
                for (int bj = 0; bj < 2; ++bj) { float g[8], v[8]; unpack8(w3[m][bj], g);
#pragma unroll
                    for (int e = 0; e < 4; ++e) { v[e] = g[e] * acc[ai][bj][m][0][e]; v[4 + e] = g[4 + e] * acc[ai][bj][m][1][e]; }
                    *(u32x4*)(Mb + (size_t)row * DM + col0 + bj * 128) = pack8(v); } } }
    }
};
struct EpiRes {
    static constexpr bool PERM = true, AFTER_DRAIN = false, HAS_MID = false;
    const float* xsrc; float* xdst; float* zp; const float* gx;
    DEV void operator()(const f32x4 (&acc)[2][2][4][2], const Unit& u, int wr, int wc, int fr, int fq) const {
        if (u.pm >= 64) { zp_store(acc, u, wr, wc, fr, fq, zp, DM); return; }
        const int row0 = u.pm * 256 + wr * 64 + fr, col0 = u.pn * 256 + wc * 32 + 8 * fq;
        f32x4 gg[2][2];
#pragma unroll
        for (int bj = 0; bj < 2; ++bj) { gg[bj][0] = *(const f32x4*)(gx + col0 + bj * 128); gg[bj][1] = *(const f32x4*)(gx + col0 + bj * 128 + 4); }
#pragma unroll
        for (int ai = 0; ai < 2; ++ai) { f32x4 sv[4][2][2];
#pragma unroll
            for (int m = 0; m < 4; ++m) { const float* sp = xsrc + (size_t)(row0 + ai * 128 + m * 16) * DM + col0;
#pragma unroll
                for (int bj = 0; bj < 2; ++bj) { sv[m][bj][0] = *(const f32x4*)(sp + bj * 128); sv[m][bj][1] = *(const f32x4*)(sp + bj * 128 + 4); } }
            asm volatile("" ::: "memory");
#pragma unroll
            for (int m = 0; m < 4; ++m) { float* dp = xdst + (size_t)(row0 + ai * 128 + m * 16) * DM + col0;
#pragma unroll
                for (int bj = 0; bj < 2; ++bj) { *(f32x4*)(dp + bj * 128) = sv[m][bj][0] + gg[bj][0] * acc[ai][bj][m][0]; *(f32x4*)(dp + bj * 128 + 4) = sv[m][bj][1] + gg[bj][1] * acc[ai][bj][m][1]; } } }
    }
};
struct EpiRelu2 {
    static constexpr bool PERM = true, AFTER_DRAIN = false, HAS_MID = false;
    bf16* O; float* zp;
    DEV void operator()(const f32x4 (&acc)[2][2][4][2], const Unit& u, int wr, int wc, int fr, int fq) const {
        if (u.pm >= 64) { zp_store(acc, u, wr, wc, fr, fq, zp, DFF); return; }
        const int row0 = u.pm * 256 + wr * 64 + fr, col0 = u.pn * 256 + wc * 32 + 8 * fq;
#pragma unroll
        for (int ai = 0; ai < 2; ++ai)
#pragma unroll
            for (int m = 0; m < 4; ++m) { bf16* rowp = O + (size_t)(row0 + ai * 128 + m * 16) * DFF + col0;
#pragma unroll
                for (int bj = 0; bj < 2; ++bj) { float v[8];
#pragma unroll
                    for (int e = 0; e < 4; ++e) { float a = fmaxf(acc[ai][bj][m][0][e], 0.f), b = fmaxf(acc[ai][bj][m][1][e], 0.f); v[e] = a * a; v[4 + e] = b * b; }
                    *(u32x4*)(rowp + bj * 128) = pack8(v); } }
    }
};

#define XB_TMO      128
#define XB_XCNT(j)  (256  + 64 * (j))
#define XB_XSUB(j)  (1280 + 64 * (j))
#define XB_XGEN(j)  (2304 + 64 * (j))
#define XB_TOP      3328
#define XB_TOPGEN   3392
#define XCD_BAR_WORDS 3456
#define XB_SPIN_CAP (1u << 18)

__device__ __forceinline__ unsigned xb_ld(unsigned* p)              { return __hip_atomic_load(p, __ATOMIC_RELAXED, __HIP_MEMORY_SCOPE_AGENT); }
__device__ __forceinline__ unsigned xb_add(unsigned* p, unsigned v) { return __hip_atomic_fetch_add(p, v, __ATOMIC_RELAXED, __HIP_MEMORY_SCOPE_AGENT); }
__device__ __forceinline__ unsigned xb_xcc_id() { return (unsigned)__builtin_amdgcn_s_getreg((3 << 11) | 20) & 0xFu; }
#define XB_SPIN(cond, bar) do { unsigned _sp = 0; while (cond) { __builtin_amdgcn_s_sleep(1); \
    if ((++_sp & 255u) == 0u) { if (xb_ld(&(bar)[XB_TMO])) break; if (_sp > XB_SPIN_CAP) { atomicAdd(&(bar)[XB_TMO], 1u); break; } } } } while (0)

struct XcdBarrier {
    unsigned* bar; unsigned x;
    volatile LAS unsigned* st;
};

__device__ __forceinline__ XcdBarrier xcd_barrier_post(unsigned* bar, volatile LAS unsigned* st) {
    XcdBarrier b; b.bar = bar; b.x = xb_xcc_id(); b.st = st;
    if (threadIdx.x == 0) (void)xb_add(&bar[XB_XCNT(b.x)], 1u);
    return b;
}
__device__ __forceinline__ void xcd_barrier_complete(unsigned* bar, unsigned x, unsigned& nloc, unsigned& nx) {
    const unsigned G = gridDim.x * gridDim.y * gridDim.z;
    unsigned sum, cnt, mine, sp = 0u;
    for (;;) {
        sum = 0u; cnt = 0u; mine = 0u;
#pragma unroll
        for (unsigned j = 0; j < 16; ++j) { const unsigned c = xb_ld(&bar[XB_XCNT(j)]); sum += c; cnt += (c > 0u) ? 1u : 0u; mine = (j == x) ? c : mine; }
        if (sum == G) break;
        __builtin_amdgcn_s_sleep(1);
        if ((++sp & 255u) == 0u) { if (xb_ld(&bar[XB_TMO])) break; if (sp > XB_SPIN_CAP) { atomicAdd(&bar[XB_TMO], 1u); break; } }
    }
    nloc = mine > 0u ? mine : 1u; nx = cnt > 0u ? cnt : 1u;
}

__device__ __forceinline__ void xcd_barrier(const XcdBarrier& b) {
    asm volatile("s_waitcnt vmcnt(0)" ::: "memory");
    __syncthreads();
    if (threadIdx.x == 0) {
        unsigned* bar = b.bar;
        __builtin_amdgcn_s_waitcnt(0);
        unsigned nloc = b.st[0], nx = b.st[1];
        if (nloc == 0u) { xcd_barrier_complete(bar, b.x, nloc, nx); b.st[0] = nloc; b.st[1] = nx; }
        const unsigned old = xb_add(&bar[XB_XSUB(b.x)], 1u);
        const unsigned gen = old / nloc;
        if (old + 1u == (gen + 1u) * nloc) {
            __builtin_amdgcn_fence(__ATOMIC_RELEASE, "agent");
            asm volatile("s_waitcnt vmcnt(0)" ::: "memory");
            const unsigned og = xb_add(&bar[XB_TOP], 1u);
            const unsigned tg = og / nx;
            if (og + 1u == (tg + 1u) * nx) xb_add(&bar[XB_TOPGEN], 1u);
            else XB_SPIN(xb_ld(&bar[XB_TOPGEN]) == tg, bar);
            __builtin_amdgcn_fence(__ATOMIC_ACQUIRE, "agent");
            xb_add(&bar[XB_XGEN(b.x)], 1u);
            asm volatile("s_waitcnt vmcnt(0)" ::: "memory");
        } else {
            XB_SPIN(xb_ld(&bar[XB_XGEN(b.x)]) == gen, bar);
            __builtin_amdgcn_fence(__ATOMIC_ACQUIRE, "agent");
            asm volatile("s_waitcnt vmcnt(0)" ::: "memory");
        }
    }
    __syncthreads();
}
struct Args { const float* in[30]; float* out; unsigned char* ws; };
typedef const __attribute__((address_space(4))) Args* KA;
DEV KA kargs() { KA p = (KA)__builtin_amdgcn_kernarg_segment_ptr(); asm volatile("" : "+s"(p)); return p; }

DEV void transpose_item(const float* W, int K, int N, bf16* WT, LAS float* scr, int item, int lane, int ldw = 0) {
    if (ldw == 0) ldw = K;
    const int nblk = N / 32, kb = item / nblk, nb = item % nblk, k0 = 64 * kb, n0 = 32 * nb;
#pragma unroll 8
    for (int i = 0; i < 32; ++i) { const int kk = 2 * i + (lane >> 5); scr[kk * 33 + (lane & 31)] = W[(size_t)(k0 + kk) * N + n0 + (lane & 31)]; }
    asm volatile("s_waitcnt lgkmcnt(0)" ::: "memory");
    const int c = lane & 7;
#pragma unroll
    for (int j = 0; j < 4; ++j) { const int n = (lane >> 3) + 8 * j; const LAS float* s = scr + (8 * c) * 33 + n;
        u32x4 o; o.x = cvtpk(s[0 * 33], s[1 * 33]); o.y = cvtpk(s[2 * 33], s[3 * 33]); o.z = cvtpk(s[4 * 33], s[5 * 33]); o.w = cvtpk(s[6 * 33], s[7 * 33]);
        *(u32x4*)(WT + (size_t)(n0 + n) * ldw + k0 + 8 * c) = o; }
    asm volatile("s_waitcnt lgkmcnt(0)" ::: "memory");
}
DEV void convert_weights(KA a, int l, LAS unsigned char* lds, int gw, int NGW, int wave, int lane, int part  ) {
    LAS float* scr = (LAS float*)(lds + wave * 16384);
    unsigned char* ws = a->ws;
    constexpr int I_IN = 32 * 376, I_GLU = 8 * 16, I_BR = 8 * 64, I_OUT = 32 * 64, I_1 = 32 * 256, I_2 = 128 * 64;
    constexpr int NITEMS = I_IN + I_GLU + 4 * I_BR + I_OUT + I_1 + I_2;
    const int it0 = (part == 2) ? I_IN : 0, it1 = (part == 1) ? I_IN : NITEMS;
    for (int it = it0 + gw; it < it1; it += NGW) {
        int r = it;
        if (r < I_IN) { transpose_item(a->in[8] + (size_t)l * DM * NIN, DM, NIN, (bf16*)(ws + WS_WIN), scr, r, lane); continue; } r -= I_IN;
        if (r < I_GLU) { transpose_item(a->in[18] + (size_t)l * MW * MW, MW, MW, (bf16*)(ws + WS_WGLU), scr, r, lane); continue; } r -= I_GLU;
        if (r < 4 * I_BR) { const int br = r / I_BR; transpose_item(a->in[25] + (size_t)(l * 4 + br) * MW * DM, MW, DM, (bf16*)(ws + WS_WBR) + (size_t)br * MW, scr, r % I_BR, lane, DM); continue; } r -= 4 * I_BR;
        if (r < I_OUT) { transpose_item(a->in[26] + (size_t)l * DM * DM, DM, DM, (bf16*)(ws + WS_WOUT), scr, r, lane); continue; } r -= I_OUT;
        if (r < I_1) { transpose_item(a->in[27] + (size_t)l * DM * DFF, DM, DFF, (bf16*)(ws + WS_W1), scr, r, lane); continue; } r -= I_1;
        transpose_item(a->in[28] + (size_t)l * DFF * DM, DFF, DM, (bf16*)(ws + WS_W2), scr, r, lane);
    }
}
DEV void modp_items(KA a, int gw, int NGW, int lane) {
    float* MODP = (float*)(a->ws + WS_MODP);
    for (int it = gw; it < 2 * 48 * 32; it += NGW) {
        const int l = it / (48 * 32), r = it % (48 * 32), cgp = r / 32, ks = r % 32;
        const float* W = a->in[4] + (size_t)l * DM * 12288 + (size_t)(64 * ks) * 12288 + 256 * cgp + 4 * lane;
        const float* cv = a->in[1] + 64 * ks; const float* cz = a->in[3] + 64 * ks;
        f32x4 ax = {0.f, 0.f, 0.f, 0.f}, az = {0.f, 0.f, 0.f, 0.f};
#pragma unroll 8
        for (int k = 0; k < 64; ++k) { const f32x4 w = *(const f32x4*)(W + (size_t)k * 12288); const float c1 = cv[k], c2 = cz[k];
            const float s1 = c1 * sigmoidf_(c1), s2 = c2 * sigmoidf_(c2); ax += w * s1; az += w * s2; }
        float* o = MODP + ((size_t)(l * 32 + ks) * 2) * 12288 + 256 * cgp + 4 * lane;
        *(f32x4*)o = ax; *(f32x4*)(o + 12288) = az;
    }
}
DEV void modv_reduce(KA a, int gtid, int NGT) {
    const float* MODP = (const float*)(a->ws + WS_MODP); float* MODV = (float*)(a->ws + WS_MODV);
    for (int i = gtid; i < 2 * 2 * 12288; i += NGT) { const int l = i / (2 * 12288), xz = (i / 12288) & 1, j = i % 12288;
        float s = a->in[5][l * 12288 + j];
        for (int ks = 0; ks < 32; ++ks) s += MODP[((size_t)(l * 32 + ks) * 2 + xz) * 12288 + j];
        MODV[i] = s; }
    f32x2* rope = (f32x2*)(a->ws + WS_ROPE);
    for (int i = gtid; i < 256 * 16; i += NGT) { const int pos = i >> 4, p = i & 15;
        const float freq = powf(10000.0f, -(float)p / 16.0f); const float ang = (float)pos * freq;
        rope[i] = (f32x2){cosf(ang), sinf(ang)}; }
}
DEV void norm_rows(const float* xsrc, const float* zsrc, const float* g, const float* modx, const float* modz, int ishift, int iscale, bf16* H, int nrows, int gw, int NGW, int lane,
                   const float* zp, int zS, const float* zgate, float* zdst) {
    for (int row = gw; row < nrows; row += NGW) {
        const bool isz = row >= L;
        const float* xr = isz ? zsrc + (size_t)(row - L) * DM : xsrc + (size_t)row * DM;
        const float* mod = isz ? modz : modx;
        f32x4 v[8]; float s = 0.f;
#pragma unroll
        for (int j = 0; j < 8; ++j) v[j] = *(const f32x4*)(xr + 4 * lane + 256 * j);
        if (isz && zp) {
#pragma unroll
            for (int j = 0; j < 8; ++j) { const int c = 4 * lane + 256 * j; f32x4 t = {0.f, 0.f, 0.f, 0.f};
                for (int ks = 0; ks < zS; ++ks) t += *(const f32x4*)(zp + ((size_t)ks * 256 + (row - L)) * DM + c);
                v[j] += *(const f32x4*)(zgate + c) * t; *(f32x4*)(zdst + (size_t)(row - L) * DM + c) = v[j]; } }
#pragma unroll
        for (int j = 0; j < 8; ++j) s += (v[j].x * v[j].x + v[j].y * v[j].y) + (v[j].z * v[j].z + v[j].w * v[j].w);
        const float rstd = 1.0f / sqrtf(wave_sum(s) * (1.0f / DM) + 1e-6f);
#pragma unroll
        for (int j = 0; j < 8; ++j) { const int c = 4 * lane + 256 * j;
            const f32x4 gg = *(const f32x4*)(g + c), sh = *(const f32x4*)(mod + ishift * DM + c), sc = *(const f32x4*)(mod + iscale * DM + c);
            const f32x4 y = (v[j] * rstd) * gg; const f32x4 h = y * (sc + 1.0f) + sh;
            u32x2 w; w.x = cvtpk(h.x, h.y); w.y = cvtpk(h.z, h.w); *(u32x2*)(H + (size_t)row * DM + c) = w; }
    }
}
DEV void zfin_relu2(const float* zp, int zS, bf16* HM, int gtid, int NGT) {
    for (int i = gtid; i < 256 * (DFF / 8); i += NGT) { const int r = i / (DFF / 8), c8 = (i % (DFF / 8)) * 8; f32x4 t0 = {0.f, 0.f, 0.f, 0.f}, t1 = {0.f, 0.f, 0.f, 0.f};
        for (int ks = 0; ks < zS; ++ks) { const float* p = zp + ((size_t)ks * 256 + r) * DFF + c8; t0 += *(const f32x4*)p; t1 += *(const f32x4*)(p + 4); }
        float v[8];
#pragma unroll
        for (int e = 0; e < 4; ++e) { const float a0 = fmaxf(t0[e], 0.f), a1 = fmaxf(t1[e], 0.f); v[e] = a0 * a0; v[4 + e] = a1 * a1; }
        *(u32x4*)(HM + (size_t)(L + r) * DFF + c8) = pack8(v); }
}
DEV void final_rows(float* x, const float* g, int gw, int NGW, int lane) {
    for (int row = gw; row < L; row += NGW) {
        float* xr = x + (size_t)row * DM; f32x4 v[8]; float s = 0.f;
#pragma unroll
        for (int j = 0; j < 8; ++j) { v[j] = *(const f32x4*)(xr + 4 * lane + 256 * j); s += (v[j].x * v[j].x + v[j].y * v[j].y) + (v[j].z * v[j].z + v[j].w * v[j].w); }
        const float rstd = 1.0f / sqrtf(wave_sum(s) * (1.0f / DM) + 1e-6f);
#pragma unroll
        for (int j = 0; j < 8; ++j) { const int c = 4 * lane + 256 * j; *(f32x4*)(xr + c) = (v[j] * rstd) * *(const f32x4*)(g + c); }
    }
}

struct AttnSt { f32x4 o[4]; float m, l; };
struct KVF { bf16x8 k[4]; u32x2 v[8]; };
DEV void k_load(KVF& f, const bf16* K, int bA, int bB, int fr, int g) {
    const unsigned lo = (unsigned)(fr * 64 + 8 * g);
    const bf16* ka = K + (size_t)__builtin_amdgcn_readfirstlane(bA) * 64; const bf16* kb = K + (size_t)__builtin_amdgcn_readfirstlane(bB) * 64;
    f.k[0] = *(const bf16x8*)(ka + lo); f.k[1] = *(const bf16x8*)(ka + lo + 32); f.k[2] = *(const bf16x8*)(kb + lo); f.k[3] = *(const bf16x8*)(kb + lo + 32);
}
DEV void v_load(KVF& f, const bf16* V, int bA, int bB, int fr, int g) {
    const unsigned lo = (unsigned)(fr * 16 + 4 * g);
    const bf16* va = V + (size_t)__builtin_amdgcn_readfirstlane(bA >> 4) * 1024; const bf16* vb = V + (size_t)__builtin_amdgcn_readfirstlane(bB >> 4) * 1024;
#pragma unroll
    for (int d = 0; d < 4; ++d) { f.v[d] = *(const u32x2*)(va + lo + d * 256); f.v[4 + d] = *(const u32x2*)(vb + lo + d * 256); }
}
DEV void kv_load(KVF& f, const bf16* K, const bf16* V, int bA, int bB, int fr, int g) { k_load(f, K, bA, bB, fr, g); v_load(f, V, bA, bB, fr, g); }
DEV void attn_compute(AttnSt& st, const bf16x8 q0, const bf16x8 q1, const KVF& f, f32x4 bA, f32x4 bB) {
    f32x4 sA = {0.f, 0.f, 0.f, 0.f}, sB = {0.f, 0.f, 0.f, 0.f};
    sA = __builtin_amdgcn_mfma_f32_16x16x32_bf16(f.k[0], q0, sA, 0, 0, 0); sA = __builtin_amdgcn_mfma_f32_16x16x32_bf16(f.k[1], q1, sA, 0, 0, 0);
    sB = __builtin_amdgcn_mfma_f32_16x16x32_bf16(f.k[2], q0, sB, 0, 0, 0); sB = __builtin_amdgcn_mfma_f32_16x16x32_bf16(f.k[3], q1, sB, 0, 0, 0);
    float tm = -1e30f;
#pragma unroll
    for (int i = 0; i < 4; ++i) { sA[i] = (bA[i] <= -1e29f) ? -1e30f : sA[i] * 0.125f + bA[i]; sB[i] = (bB[i] <= -1e29f) ? -1e30f : sB[i] * 0.125f + bB[i]; tm = fmaxf(tm, fmaxf(sA[i], sB[i])); }
    tm = fmaxf(tm, __shfl_xor(tm, 16)); tm = fmaxf(tm, __shfl_xor(tm, 32));
    const float mn = fmaxf(st.m, tm), alpha = __expf(st.m - mn); st.m = mn;
    float ps = 0.f; float pa[4], pb[4];
#pragma unroll
    for (int i = 0; i < 4; ++i) { pa[i] = __expf(sA[i] - mn); pb[i] = __expf(sB[i] - mn); ps += pa[i] + pb[i]; }
    st.l = st.l * alpha + ps;
    u32x4 pw; pw.x = cvtpk(pa[0], pa[1]); pw.y = cvtpk(pa[2], pa[3]); pw.z = cvtpk(pb[0], pb[1]); pw.w = cvtpk(pb[2], pb[3]);
    const bf16x8 pfrag = __builtin_bit_cast(bf16x8, pw);
#pragma unroll
    for (int d = 0; d < 4; ++d) { u32x4 vw; vw.x = f.v[d].x; vw.y = f.v[d].y; vw.z = f.v[4 + d].x; vw.w = f.v[4 + d].y;
        st.o[d] = st.o[d] * alpha; st.o[d] = __builtin_amdgcn_mfma_f32_16x16x32_bf16(__builtin_bit_cast(bf16x8, vw), pfrag, st.o[d], 0, 0, 0); }
}
DEV void attn_finish(const AttnSt& st, bf16* yrow  ) {
    float l = st.l; l += __shfl_xor(l, 16); l += __shfl_xor(l, 32);
    const float inv = 1.0f / l;
#pragma unroll
    for (int d = 0; d < 4; ++d) { u32x2 w; w.x = cvtpk(st.o[d][0] * inv, st.o[d][1] * inv); w.y = cvtpk(st.o[d][2] * inv, st.o[d][3] * inv); *(u32x2*)(yrow + 16 * d) = w; }
}
DEV void attnA_item(KA a, int l, int item, bool isctx, int lane) {
    const bf16* PA = (const bf16*)(a->ws + WS_PA); bf16* Y = (bf16*)(a->ws + WS_Y);
    const int fr = lane & 15, g = lane >> 4, hk = item & 1, qb = item >> 1, q0 = (isctx ? L : 0) + 16 * qb, qt = q0 + fr;
    const bf16* K = (const bf16*)(a->ws + WS_KA) + (size_t)hk * MT * 64; const bf16* V = (const bf16*)(a->ws + WS_VTA) + (size_t)hk * (MT / 16) * 1024;
    bf16x8 qf[4][2]; AttnSt st[4];
#pragma unroll
    for (int s = 0; s < 4; ++s) { const bf16* qp = PA + (size_t)qt * NPA + (hk * 4 + s) * 64 + 8 * g; qf[s][0] = *(const bf16x8*)qp; qf[s][1] = *(const bf16x8*)(qp + 32);
        st[s].m = a->in[9][l * 8 + hk * 4 + s]; st[s].l = (g == 0) ? 1.0f : 0.0f;
#pragma unroll
        for (int d = 0; d < 4; ++d) st[s].o[d] = (f32x4){0.f, 0.f, 0.f, 0.f}; }
    const int NP = isctx ? 8 : 17;
    KVF cur, nxt; kv_load(cur, K, V, L, L + 16, fr, g);
    for (int pi = 0; pi < NP; ++pi) {
        { const int pn = (pi + 1 < NP) ? pi + 1 : pi; int bA, bB;
          if (pn < 8) { bA = L + 32 * pn; bB = bA + 16; } else { bA = q0 - 128 + 32 * (pn - 8); bB = bA + 16; bA = (bA >= 0 && bA < L) ? bA : 0; bB = (bB >= 0 && bB < L) ? bB : 0; }
          kv_load(nxt, K, V, bA, bB, fr, g); }
        f32x4 m0 = {0.f, 0.f, 0.f, 0.f}, m1 = {0.f, 0.f, 0.f, 0.f};
        if (pi >= 8) { const int b0 = q0 - 128 + 32 * (pi - 8), b1 = b0 + 16; const bool ok0 = (b0 >= 0) && (b0 < L), ok1 = (b1 >= 0) && (b1 < L);
#pragma unroll
            for (int i = 0; i < 4; ++i) { const int d0 = b0 + 4 * g + i - qt, d1 = b1 + 4 * g + i - qt;
                m0[i] = (ok0 && d0 >= -128 && d0 <= 128) ? 0.f : -1e30f; m1[i] = (ok1 && d1 >= -128 && d1 <= 128) ? 0.f : -1e30f; } }
#pragma unroll
        for (int s = 0; s < 4; ++s) attn_compute(st[s], qf[s][0], qf[s][1], cur, m0, m1);
        cur = nxt;
    }
#pragma unroll
    for (int s = 0; s < 4; ++s) attn_finish(st[s], Y + (size_t)qt * DM + (hk * 4 + s) * 64 + 4 * g);
}
DEV void attnC_item(KA a, int l, int item, bool isctx, LAS float* rps, int lane) {
    const bf16* PA = (const bf16*)(a->ws + WS_PA); bf16* Y = (bf16*)(a->ws + WS_Y);
    const int fr = lane & 15, g = lane >> 4, h = item & 7, r = item >> 3, q0 = isctx ? L + 64 * r : 64 * r;
    const bf16* K = (const bf16*)(a->ws + WS_KC) + (size_t)h * MT * 64; const bf16* V = (const bf16*)(a->ws + WS_VTC) + (size_t)h * (MT / 16) * 1024;
    if (!isctx) { const float* rpb = a->in[20] + (size_t)(l * 8 + h) * 465; for (int i = lane; i < 465; i += 64) rps[i] = rpb[i]; }
    bf16x8 qf[4][2]; AttnSt st[4];
#pragma unroll
    for (int s = 0; s < 4; ++s) { const bf16* qp = PA + (size_t)(q0 + 16 * s + fr) * NPA + 1280 + h * 64 + 8 * g; qf[s][0] = *(const bf16x8*)qp; qf[s][1] = *(const bf16x8*)(qp + 32);
        st[s].m = -1e30f; st[s].l = 0.f;
#pragma unroll
        for (int d = 0; d < 4; ++d) st[s].o[d] = (f32x4){0.f, 0.f, 0.f, 0.f}; }
    const int krow0 = min(max(r - 4, 0), 248);
    KVF cur, nxt; kv_load(cur, K, V, L, L + 16, fr, g);
    for (int pi = 0; pi < 8; ++pi) {
        { int bA = (pi < 7) ? L + 32 * (pi + 1) : (isctx ? L : krow0 * 64); kv_load(nxt, K, V, bA, bA + 16, fr, g); }
        const f32x4 z = {0.f, 0.f, 0.f, 0.f};
#pragma unroll
        for (int s = 0; s < 4; ++s) attn_compute(st[s], qf[s][0], qf[s][1], cur, z, z);
        cur = nxt;
    }
    if (!isctx) {
#define C_MASKS(s, pp) const int qcol = 16 * (s) + fr, cstart = min(max(qcol - 8, 0), 48); f32x4 m0, m1; \
        _Pragma("unroll") for (int i = 0; i < 4; ++i) { const int kc0 = 32 * (pp) + 4 * g + i, kc1 = kc0 + 16; \
            m0[i] = (kc0 >= cstart && kc0 < cstart + 16) ? rp[kc0 - qcol + 15] : -1e30f; m1[i] = (kc1 >= cstart && kc1 < cstart + 16) ? rp[kc1 - qcol + 15] : -1e30f; }
        for (int i8 = 0; i8 < 8; ++i8) {
            const int krow = krow0 + i8; const LAS float* rp = rps + (krow - r + 7) * 31;
            k_load(nxt, K, krow * 64 + 32, krow * 64 + 48, fr, g);
#pragma unroll
            for (int s = 0; s < 3; ++s) { C_MASKS(s, 0) attn_compute(st[s], qf[s][0], qf[s][1], cur, m0, m1); }
            v_load(cur, V, krow * 64 + 32, krow * 64 + 48, fr, g);
#pragma unroll
            for (int q = 0; q < 4; ++q) cur.k[q] = nxt.k[q];
            { const int kn = (i8 < 7) ? krow + 1 : krow; k_load(nxt, K, kn * 64, kn * 64 + 16, fr, g); }
#pragma unroll
            for (int s = 1; s < 4; ++s) { C_MASKS(s, 1) attn_compute(st[s], qf[s][0], qf[s][1], cur, m0, m1); }
            { const int kn = (i8 < 7) ? krow + 1 : krow; v_load(cur, V, kn * 64, kn * 64 + 16, fr, g); }
#pragma unroll
            for (int q = 0; q < 4; ++q) cur.k[q] = nxt.k[q];
        }
#undef C_MASKS
    }
#pragma unroll
    for (int s = 0; s < 4; ++s) attn_finish(st[s], Y + (size_t)(q0 + 16 * s + fr) * DM + 1024 + h * 64 + 4 * g);
}

DEV void conv_item(KA a, int l, int item, LAS unsigned char* lds, int tid) {
    const bf16* PA = (const bf16*)(a->ws + WS_PA); bf16* Y = (bf16*)(a->ws + WS_Y);
    LAS float* hs = (LAS float*)lds;
    LAS float* ys = (LAS float*)(lds + 46 * 512 * 4);
    const bool isz = item >= L / 16; const int rowbase = isz ? L : 0, seqlen = isz ? LC : L, t0 = (isz ? item - L / 16 : item) * 16;
    for (int idx = tid; idx < 46 * 64; idx += NTHR) { const int tt = t0 - 15 + (idx >> 6), c8 = (idx & 63) * 8; float h[8];
        if (tt >= 0 && tt < seqlen) { float v[8], gt[8]; const bf16* p = PA + (size_t)(rowbase + tt) * NPA + 2816 + c8;
            unpack8(*(const u32x4*)p, v); unpack8(*(const u32x4*)(p + 512), gt);
#pragma unroll
            for (int e = 0; e < 8; ++e) h[e] = v[e] * sigmoidf_(gt[e]); }
        else {
#pragma unroll
            for (int e = 0; e < 8; ++e) h[e] = 0.f; }
        LAS float* d = hs + (idx >> 6) * 512 + c8; *(LAS f32x4*)d = (f32x4){h[0], h[1], h[2], h[3]}; *(LAS f32x4*)(d + 4) = (f32x4){h[4], h[5], h[6], h[7]}; }
    __syncthreads();
    { const int ch = tid; float w[31]; const float* wp = a->in[21] + (size_t)l * 31 * 512 + ch;
#pragma unroll
        for (int k = 0; k < 31; ++k) w[k] = wp[k * 512];
        const float b = a->in[22][l * 512 + ch];
        for (int tok = 0; tok < 16; ++tok) { float y = b;
#pragma unroll
            for (int k = 0; k < 31; ++k) y += hs[(tok + k) * 512 + ch] * w[k];
            ys[tok * 512 + ch] = y; } }
    __syncthreads();
    { const int wave = tid >> 6, lane = tid & 63;
        const float* lg = a->in[23] + l * 512; const float* lb = a->in[24] + l * 512;
        for (int tt = 0; tt < 2; ++tt) { const int tok = wave * 2 + tt; float y[8]; float s = 0.f;
#pragma unroll
            for (int j = 0; j < 8; ++j) { y[j] = ys[tok * 512 + lane + 64 * j]; s += y[j]; }
            const float mu = wave_sum(s) * (1.0f / 512.0f); float q = 0.f;
#pragma unroll
            for (int j = 0; j < 8; ++j) { y[j] -= mu; q += y[j] * y[j]; }
            const float rstd = 1.0f / sqrtf(wave_sum(q) * (1.0f / 512.0f) + 1e-6f);
            bf16* yr = Y + (size_t)(rowbase + t0 + tok) * DM + 1536;
#pragma unroll
            for (int j = 0; j < 8; ++j) { const int ch = lane + 64 * j; const float yn = y[j] * rstd * lg[ch] + lb[ch]; yr[ch] = f2bf1(yn * sigmoidf_(yn)); } } }
    __syncthreads();
}

DEV int s5_row(int dir, int s) { return dir == 0 ? (s < LC ? L + s : s - LC) : (MT - 1 - s); }
typedef short bf16x4 __attribute__((ext_vector_type(4)));
constexpr size_t WS_S5BB = WS_MODP, WS_S5AB = WS_MODP + 1 * MiB;
DEV void s5_tables(KA a, int l, int gtid, int NGT) {
    float* BB = (float*)(a->ws + WS_S5BB); f32x2* AB = (f32x2*)(a->ws + WS_S5AB);
    for (int i = gtid; i < 64 * 64; i += NGT) { const int dg = i >> 6, p = i & 63, ig = l * 64 + dg;
        const float are = a->in[10][ig * 64 + p], aim = a->in[11][ig * 64 + p];
        const float step = expf(a->in[12][ig]);
        const float mag = expf(are * step); float sn, cs; sincosf(aim * step, &sn, &cs);
        const float abr = mag * cs, abi = mag * sn, den = are * are + aim * aim, nr = abr - 1.0f;
        const float fre = (nr * are + abi * aim) / den, fim = (abi * are - nr * aim) / den;
        AB[i] = (f32x2){abr, abi};
        const float* br = a->in[13] + ((size_t)ig * 64 + p) * 16; const float* bi = a->in[14] + ((size_t)ig * 64 + p) * 16;
        float* o = BB + ((size_t)dg * 128 + 2 * p) * 16;
#pragma unroll
        for (int h = 0; h < 16; ++h) { o[h] = fre * br[h] - fim * bi[h]; o[16 + h] = fre * bi[h] + fim * br[h]; } }
}
struct S5F { f32x2 a, an; bf16x4 bhi[8], blo[8]; };
DEV void s5_load(KA a, int dg, int lane, S5F& F) {
    const float* BB = (const float*)(a->ws + WS_S5BB) + (size_t)dg * 128 * 16; const f32x2* AB = (const f32x2*)(a->ws + WS_S5AB) + dg * 64;
    F.a = AB[lane]; F.an = (f32x2){-F.a.y, F.a.x};
    const int fr = lane & 15, g4 = lane >> 4;
#pragma unroll
    for (int nt = 0; nt < 8; ++nt) { const f32x4 w = *(const f32x4*)(BB + (16 * nt + fr) * 16 + 4 * g4);
        u32x2 hi; hi.x = cvtpk(w[0], w[1]); hi.y = cvtpk(w[2], w[3]);
        u32x2 lo; lo.x = cvtpk(w[0] - bflo(hi.x), w[1] - bfhi(hi.x)); lo.y = cvtpk(w[2] - bflo(hi.y), w[3] - bfhi(hi.y));
        F.bhi[nt] = __builtin_bit_cast(bf16x4, hi); F.blo[nt] = __builtin_bit_cast(bf16x4, lo); }
}
DEV bf16x4 s5_ufrag(const bf16* PA, int dir, int g, int s0, int lane) {
    return *(const bf16x4*)(PA + (size_t)s5_row(dir, s0 + (lane & 15)) * NPA + 768 + 16 * g + 4 * (lane >> 4));
}
DEV void s5_drive(const S5F& F, bf16x4 uf, LAS float* Dr, int lane) {
    const int fr = lane & 15, g4 = lane >> 4;
#pragma unroll
    for (int nt = 0; nt < 8; ++nt) { f32x4 acc = {0.f, 0.f, 0.f, 0.f};
        acc = __builtin_amdgcn_mfma_f32_16x16x16bf16_1k(uf, F.bhi[nt], acc, 0, 0, 0); acc = __builtin_amdgcn_mfma_f32_16x16x16bf16_1k(uf, F.blo[nt], acc, 0, 0, 0);
#pragma unroll
        for (int i = 0; i < 4; ++i) Dr[(4 * g4 + i) * 132 + 16 * nt + fr] = acc[i]; }
    asm volatile("s_waitcnt lgkmcnt(0)" ::: "memory");
}
DEV void s5_pass1_wave(KA a, int l, int dg, int c0, int cstep, LAS unsigned char* wlds, int lane) {
    const int dir = dg >> 5, g = dg & 31;
    const bf16* PA = (const bf16*)(a->ws + WS_PA);
    S5F F; s5_load(a, dg, lane, F);
    LAS float* Dr = (LAS float*)wlds;
    f32x2* HEND = (f32x2*)(a->ws + WS_HEND);
    for (int c = c0; c < 260; c += cstep) {
        f32x2 h = {0.f, 0.f};
        bf16x4 uf = s5_ufrag(PA, dir, g, 64 * c, lane);
        for (int tile = 0; tile < 4; ++tile) {
            const bf16x4 un = s5_ufrag(PA, dir, g, 64 * c + 16 * (tile < 3 ? tile + 1 : tile), lane);
            s5_drive(F, uf, Dr, lane);
            f32x2 d[16];
#pragma unroll
            for (int tt = 0; tt < 16; ++tt) d[tt] = *(const LAS f32x2*)(Dr + tt * 132 + 2 * lane);
#pragma unroll
            for (int tt = 0; tt < 16; ++tt) { const f32x2 hx = {h.x, h.x}, hy = {h.y, h.y}; h = __builtin_elementwise_fma(F.a, hx, __builtin_elementwise_fma(F.an, hy, d[tt])); }
            asm volatile("s_waitcnt lgkmcnt(0)" ::: "memory");
            uf = un;
        }
        HEND[((size_t)dg * 260 + c) * 64 + lane] = h;
    }
}
DEV void s5_pass2_item(KA a, int l, int dg, int cstart, int nch, LAS unsigned char* wlds, int lane) {
    const int dir = dg >> 5, g = dg & 31, fr = lane & 15, g4 = lane >> 4;
    const bf16* PA = (const bf16*)(a->ws + WS_PA);
    S5F F; s5_load(a, dg, lane, F);
    float tr = F.a.x, ti = F.a.y;
#pragma unroll
    for (int i = 0; i < 6; ++i) { const float nr = tr * tr - ti * ti, ni = 2.f * tr * ti; tr = nr; ti = ni; }
    const f32x2* HEND = (const f32x2*)(a->ws + WS_HEND) + (size_t)dg * 260 * 64 + lane;
    float hr = 0.f, hi = 0.f;
    { const int nc = cstart; int c = 0;
      for (; c + 16 <= nc; c += 16) { f32x2 e[16];
#pragma unroll
          for (int j = 0; j < 16; ++j) e[j] = HEND[(size_t)(c + j) * 64];
#pragma unroll
          for (int j = 0; j < 16; ++j) { const float nr = tr * hr - ti * hi + e[j].x, ni = tr * hi + ti * hr + e[j].y; hr = nr; hi = ni; } }
      for (; c + 4 <= nc; c += 4) { f32x2 e[4];
#pragma unroll
          for (int j = 0; j < 4; ++j) e[j] = HEND[(size_t)(c + j) * 64];
#pragma unroll
          for (int j = 0; j < 4; ++j) { const float nr = tr * hr - ti * hi + e[j].x, ni = tr * hi + ti * hr + e[j].y; hr = nr; hi = ni; } }
      for (; c < nc; ++c) { const f32x2 e = HEND[(size_t)c * 64]; const float nr = tr * hr - ti * hi + e.x, ni = tr * hi + ti * hr + e.y; hr = nr; hi = ni; } }
    bf16x8 cf[4];
    { const int ig = (l * 2 + dir) * 32 + g; const float* cr = a->in[15] + ((size_t)ig * 16 + fr) * 64; const float* ci = a->in[16] + ((size_t)ig * 16 + fr) * 64;
#pragma unroll
        for (int ks = 0; ks < 4; ++ks) { const int p0 = 16 * ks + 4 * g4; u32x4 w;
            w.x = cvtpk(cr[p0], -ci[p0]); w.y = cvtpk(cr[p0 + 1], -ci[p0 + 1]); w.z = cvtpk(cr[p0 + 2], -ci[p0 + 2]); w.w = cvtpk(cr[p0 + 3], -ci[p0 + 3]);
            cf[ks] = __builtin_bit_cast(bf16x8, w); } }
    f32x2 hh = {hr, hi};
    LAS float* Dr = (LAS float*)wlds;
    LAS unsigned* Hs = (LAS unsigned*)(wlds + 8448);
    float* OUT = (float*)(a->ws + (dir == 0 ? WS_OUTF : WS_OUTB));
    const int sbase = 64 * cstart, ntile = 4 * nch;
    bf16x4 uf = s5_ufrag(PA, dir, g, sbase, lane);
    for (int tile = 0; tile < ntile; ++tile) {
        const bf16x4 un = s5_ufrag(PA, dir, g, sbase + 16 * (tile < ntile - 1 ? tile + 1 : tile), lane);
        s5_drive(F, uf, Dr, lane);
        f32x2 d[16];
#pragma unroll
        for (int tt = 0; tt < 16; ++tt) d[tt] = *(const LAS f32x2*)(Dr + tt * 132 + 2 * lane);
#pragma unroll
        for (int tt = 0; tt < 16; ++tt) { const f32x2 hx = {hh.x, hh.x}, hy = {hh.y, hh.y};
            hh = __builtin_elementwise_fma(F.a, hx, __builtin_elementwise_fma(F.an, hy, d[tt])); Hs[tt * 68 + lane] = cvtpk(hh.x, hh.y); }
        asm volatile("s_waitcnt lgkmcnt(0)" ::: "memory");
        f32x4 acc = {0.f, 0.f, 0.f, 0.f};
#pragma unroll
        for (int ks = 0; ks < 4; ++ks) { const bf16x8 af = *(const LAS bf16x8*)((const LAS unsigned char*)Hs + fr * 272 + 64 * ks + 16 * g4);
            acc = __builtin_amdgcn_mfma_f32_16x16x32_bf16(af, cf[ks], acc, 0, 0, 0); }
        asm volatile("s_waitcnt lgkmcnt(0)" ::: "memory");
        const int s0 = sbase + 16 * tile + 4 * g4;
#pragma unroll
        for (int i = 0; i < 4; ++i) OUT[(size_t)s5_row(dir, s0 + i) * MW + 16 * g + fr] = acc[i];
        uf = un;
    }
}
DEV void s5_glu_prep(KA a, int l, int nrows, int gtid, int NGT) {
    const bf16* PA = (const bf16*)(a->ws + WS_PA); const float* OF = (const float*)(a->ws + WS_OUTF); const float* OB = (const float*)(a->ws + WS_OUTB);
    bf16* G = (bf16*)(a->ws + WS_G); const float* dsk = a->in[17] + l * 512;
    for (int i = gtid; i < nrows * 64; i += NGT) { const int row = i >> 6, c8 = (i & 63) * 8; float u[8], o[8];
        unpack8(*(const u32x4*)(PA + (size_t)row * NPA + 768 + c8), u);
        const float* f = OF + (size_t)row * MW + c8; const float* b = OB + (size_t)row * MW + c8;
        const f32x4 f0 = *(const f32x4*)f, f1 = *(const f32x4*)(f + 4), b0 = *(const f32x4*)b, b1 = *(const f32x4*)(b + 4);
        const f32x4 d0 = *(const f32x4*)(dsk + c8), d1 = *(const f32x4*)(dsk + c8 + 4);
#pragma unroll
        for (int e = 0; e < 8; ++e) { const float y = u[e] * (e < 4 ? d0[e & 3] : d1[e & 3]) + (e < 4 ? f0[e & 3] : f1[e & 3]) + (e < 4 ? b0[e & 3] : b1[e & 3]);
            const float z = 0.7978845608028654f * (y + 0.044715f * y * y * y); const float th = 1.0f - 2.0f / (__expf(2.0f * z) + 1.0f);
            o[e] = 0.5f * y * (1.0f + th); }
        *(u32x4*)(G + (size_t)row * MW + c8) = pack8(o); }
}

template <int ID, class Epi> DEV void run_gemm(LAS unsigned char* lds, const bf16* A, int lda, const bf16* Bt, int ldb, int M, int N, int K, const Epi& E, int zS) {
    pg8::Gemm g{A, Bt, M, N, K, lda, ldb}; int bid_l = blockIdx.x; asm volatile("" : "+s"(bid_l)); pg8::StaticOrder S; S.init(M, N, K, (int)gridDim.x, bid_l, zS);
#ifndef NO_GEMM
    if constexpr (((GEMM_MASK) >> ID) & 1) pg8::gemm_phase<Epi, pg8::StaticOrder, true, true>(lds, g, S, E);
#endif
}

#define PHASE_VARS const KA a = kargs(); unsigned char* const ws = a->ws; int tid_l = threadIdx.x; asm volatile("" : "+v"(tid_l)); int bid_l = blockIdx.x; asm volatile("" : "+s"(bid_l)); const int tid = tid_l, bid = bid_l, lane = tid & 63, wave = __builtin_amdgcn_readfirstlane(tid >> 6); \
    const int G = gridDim.x, NGW = G * NWAVES, gw = bid * NWAVES + wave, NGT = G * NTHR, gtid = bid * NTHR + tid; (void)bid; LAS unsigned char* const wlds = lds + wave * 16384; \
    (void)ws; (void)lane; (void)NGW; (void)gw; (void)NGT; (void)gtid; (void)wlds; \
    const float* const MODV = (const float*)(ws + WS_MODV); const float* const modx = MODV + (size_t)(l * 2 + 0) * 12288; const float* const modz = MODV + (size_t)(l * 2 + 1) * 12288; (void)modx; (void)modz; \
    const int Mrest = (l == 0) ? MT : L; (void)Mrest;

__global__ void __launch_bounds__(NTHR, 2) fwd(Args a_formal_unused) {
    extern __shared__ __attribute__((aligned(16))) unsigned char lds_raw[];
    LAS unsigned char* const lds = (LAS unsigned char*)lds_raw;
    cg::grid_group grid = cg::this_grid();
    { const int t0 = threadIdx.x; if (t0 < 64) ((LAS unsigned*)(lds + LDS_CTL))[t0] = 0u;
      if (blockIdx.x == 0) { unsigned* bw = (unsigned*)(kargs()->ws + WS_BAR); for (int i = t0; i < XCD_BAR_WORDS; i += NTHR) bw[i] = 0u; }
      __syncthreads(); }
#define GBAR() do { XcdBarrier b_; b_.bar = (unsigned*)(kargs()->ws + WS_BAR); b_.x = xb_xcc_id(); b_.st = (volatile LAS unsigned*)(lds + LDS_CTL); xcd_barrier(b_); } while (0)

    { const int l = 0; PHASE_VARS
#ifndef NO_P0
      for (int rep_ = 0; rep_ < REP_P0; ++rep_) {
      convert_weights(a, 0, lds, gw, NGW, wave, lane, 0);
      modp_items(a, gw, NGW, lane); }
#endif
    }
    grid.sync();
    (void)xcd_barrier_post((unsigned*)(kargs()->ws + WS_BAR), (volatile LAS unsigned*)(lds + LDS_CTL));
    { const int l = 0; PHASE_VARS
      modv_reduce(a, gtid, NGT); }
    GBAR();

#pragma unroll 1
    for (int l = 0; l < 2; ++l) {
        { PHASE_VARS
          if (l == 1) for (int rep_ = 0; rep_ < REP_CW1; ++rep_) convert_weights(a, 1, lds, gw, NGW, wave, lane, 0);
          s5_tables(a, l, gtid, NGT);
          for (int rep_ = 0; rep_ < REP_NORM; ++rep_)
          norm_rows((l == 0) ? a->in[0] : a->out, (l == 0) ? a->in[2] : (const float*)(ws + WS_Z), a->in[6] + l * DM, modx, modz, 0, 1, (bf16*)(ws + WS_H), MT, gw, NGW, lane,
                    (l == 1) ? (const float*)(ws + WS_OUTF) : nullptr, 32, MODV + 12288 + 5 * DM, (float*)(ws + WS_Z)); }
        GBAR();
        { PHASE_VARS
          EpiIn E{ws};
          for (int rep_ = 0; rep_ < REP_G1; ++rep_)
          run_gemm<1>(lds, (const bf16*)(ws + WS_H), DM, (const bf16*)(ws + WS_WIN), DM, L, NIN, DM, E, 1); }
        GBAR();
        { PHASE_VARS
          const int nconv = L / 16 + (l == 0 ? LC / 16 : 0);
#ifndef NO_CONV
          for (int rep_ = 0; rep_ < REP_CONV * REP_MIXA; ++rep_)
          for (int it = bid; it < nconv; it += G) conv_item(a, l, it, lds, tid);
#endif
        }
        for (int step = 0; step < 2; ++step) {
            bool s5turn; { int tw = threadIdx.x; asm volatile("" : "+v"(tw)); s5turn = (step == 0) == (__builtin_amdgcn_readfirstlane(tw >> 6) >= 4); }
            if (!s5turn) {
        { PHASE_VARS
          for (int it = gw; it < 3072 + 32; it += NGW) { const bool cx = it >= 2048; if (cx && (l != 0 || it < 3072)) continue; attnA_item(a, l, cx ? it - 3072 : it, cx, lane); } }
        { PHASE_VARS
          for (int it = gw; it < 2048; it += NGW) attnC_item(a, l, it, false, (LAS float*)wlds, lane); }
        if (l == 0) { PHASE_VARS
          for (int it = (gw + NGW - (1536 % NGW)) % NGW; it < 32; it += NGW) attnC_item(a, l, it, true, (LAS float*)wlds, lane); }
            } else {
        { PHASE_VARS
          if ((NGW & 63) == 0) s5_pass1_wave(a, l, gw & 63, gw >> 6, NGW >> 6, wlds, lane);
          else for (int it = gw; it < 64 * 260; it += NGW) s5_pass1_wave(a, l, it / 260, it % 260, 260, wlds, lane); }
            }
        }
        GBAR();
        { PHASE_VARS
          const int c0 = (l == 0) ? 0 : 4, rl = (l == 0) ? 10 : 8, nrg = (260 - c0) / rl;
#ifndef NO_S52
          for (int rep_ = 0; rep_ < REP_MIXB; ++rep_)
          for (int it = gw; it < 64 * nrg; it += NGW) s5_pass2_item(a, l, it / nrg, c0 + rl * (it % nrg), rl, wlds, lane);
#endif
        }
        GBAR();
        { PHASE_VARS
          for (int rep_ = 0; rep_ < REP_MIXC; ++rep_) s5_glu_prep(a, l, Mrest, gtid, NGT); }
        GBAR();
        { PHASE_VARS
          EpiGlu E{ws, a->in[19] + l * 512};
          run_gemm<2>(lds, (const bf16*)(ws + WS_G), MW, (const bf16*)(ws + WS_WGLU), MW, L, MW, MW, E, (l == 0) ? 1 : 0); }
        GBAR();
        for (int rep_ = 0; rep_ < REP_G3; ++rep_)
        { PHASE_VARS
          EpiMerge E{ws};
          run_gemm<3>(lds, (const bf16*)(ws + WS_Y), DM, (const bf16*)(ws + WS_WBR), DM, L, DM, DM, E, (l == 0) ? 1 : 0); }
        GBAR();
        { PHASE_VARS
          for (int rep_ = 0; rep_ < REP_G4; ++rep_) {
          EpiRes E{(l == 0) ? a->in[0] : a->out, (rep_ + 1 < REP_G4) ? (float*)(ws + WS_PA) : a->out, (float*)(ws + WS_OUTF), modx + 2 * DM};
          run_gemm<4>(lds, (const bf16*)(ws + WS_H), DM, (const bf16*)(ws + WS_WOUT), DM, L, DM, DM, E, (l == 0) ? 16 : 0); } }
        GBAR();
        { PHASE_VARS
          for (int rep_ = 0; rep_ < REP_NORM; ++rep_)
          norm_rows(a->out, (l == 0) ? a->in[2] : (const float*)(ws + WS_Z), a->in[7] + l * DM, modx, modz, 3, 4, (bf16*)(ws + WS_H), Mrest, gw, NGW, lane,
                    (l == 0) ? (const float*)(ws + WS_OUTF) : nullptr, 16, modz + 2 * DM, (float*)(ws + WS_Z)); }
        GBAR();
        { PHASE_VARS
          EpiRelu2 E{(bf16*)(ws + WS_PG), (float*)(ws + WS_OUTF)};
          for (int rep_ = 0; rep_ < REP_G5; ++rep_)
          run_gemm<5>(lds, (const bf16*)(ws + WS_H), DM, (const bf16*)(ws + WS_W1), DM, L, DFF, DM, E, (l == 0) ? 8 : 0); }
        GBAR();
        if (l == 0) { { PHASE_VARS
          zfin_relu2((const float*)(ws + WS_OUTF), 8, (bf16*)(ws + WS_PG), gtid, NGT); }
          GBAR(); }
        { PHASE_VARS
          for (int rep_ = 0; rep_ < REP_G6; ++rep_) {
          EpiRes E{a->out, (rep_ + 1 < REP_G6) ? (float*)(ws + WS_PA) : a->out, (float*)(ws + WS_OUTF), modx + 5 * DM};
          run_gemm<6>(lds, (const bf16*)(ws + WS_PG), DFF, (const bf16*)(ws + WS_W2), DFF, L, DM, DFF, E, (l == 0) ? 32 : 0); } }
        GBAR();
    }
    for (int rep_ = 1; rep_ < REP_SYNC; ++rep_) GBAR();
    { const int l = 0; PHASE_VARS
      final_rows(a->out, a->in[29], gw, NGW, lane); }
}

extern "C" void kernel_launch(void* const* d_in, const int* in_sizes, int n_in, void* d_out, int out_size, void* d_ws, size_t ws_size, hipStream_t stream) {
    static int grid = 0;
    if (grid == 0) {
        if (n_in != 30 || out_size != L * DM || ws_size < WS_END) { fprintf(stderr, "kernel_launch: unexpected shapes: n_in %d out %d ws %zu (need %zu)\n", n_in, out_size, ws_size, (size_t)WS_END); grid = -1; return; }
        int dev = 0, cus = 0, per_cu = 0;
        (void)hipGetDevice(&dev);
        (void)hipDeviceGetAttribute(&cus, hipDeviceAttributeMultiprocessorCount, dev);
        (void)hipFuncSetAttribute((const void*)fwd, hipFuncAttributeMaxDynamicSharedMemorySize, LDS_BYTES);
        (void)hipOccupancyMaxActiveBlocksPerMultiprocessor(&per_cu, (const void*)fwd, NTHR, LDS_BYTES);
        if (per_cu < 1) per_cu = 1;
        grid = cus * per_cu;
        fprintf(stderr, "grid %d (cus %d per_cu %d) ws_size %zu\n", grid, cus, per_cu, ws_size);
    }
    if (grid < 0) return;
    Args a{};
    for (int i = 0; i < 30; ++i) a.in[i] = (const float*)d_in[i];
    a.out = (float*)d_out; a.ws = (unsigned char*)d_ws;
    void* args[] = {&a};
    hipError_t e = hipLaunchCooperativeKernel((void*)fwd, dim3(grid), dim3(NTHR), args, LDS_BYTES, stream);
    if (e != hipSuccess) fprintf(stderr, "cooperative launch failed: %s (grid %d)\n", hipGetErrorString(e), grid);
}
```
